# Optimizing an MI355X kernel written in HIP

```python
import jax, jax.numpy as jnp
from jax import lax
import numpy as np

D_MODEL = 1024
BATCH = 16
SEQ = 2048
DEPTH = 1

HEAD_DIM = 64
ATTN_HEADS = 8
ATTN_WIDTH = ATTN_HEADS * HEAD_DIM
ROPE_DIM = HEAD_DIM // 4
ROPE_THETA = 500000.0
DILATED_PATTERNS = ((128, 1), (512, 4), (2048, 16))
HG_HEADS = 4
HG_EXPAND = 128
HG_VDIM = 128
HG_KDIM = HG_HEADS * HG_EXPAND
HG_WIDTH = HG_HEADS * HG_VDIM
HG_CHUNK = 64
MIX_WIDTH = ATTN_WIDTH + HG_WIDTH
IN_SIZES = (ATTN_WIDTH, ATTN_WIDTH, ATTN_WIDTH, HG_KDIM, HG_KDIM, HG_WIDTH, HG_WIDTH)
IN_COLS = sum(IN_SIZES)
D_FF = 2816
EPS = 1e-6
NEG_INF = -1e30

kernel_name = 'hymba_longnet_hgrn2_macaron_block'


def _rms_norm(x, w):
    xf = x.astype(jnp.float32)
    y = xf * lax.rsqrt(jnp.mean(xf * xf, axis=-1, keepdims=True) + EPS)
    return (y * w.astype(jnp.float32)).astype(x.dtype)


def _swiglu(h, w1, w3, w2):
    return (jax.nn.silu(h @ w1) * (h @ w3)) @ w2


def _rope_tables(s):
    inv = ROPE_THETA ** (-jnp.arange(0, ROPE_DIM, 2, dtype=jnp.float32) / ROPE_DIM)
    ang = jnp.arange(s, dtype=jnp.float32)[:, None] * inv[None, :]
    return jnp.cos(ang), jnp.sin(ang)


def _partial_rope(x, cos, sin):
    half = ROPE_DIM // 2
    xf = x.astype(jnp.float32)
    x1, x2, rest = xf[..., :half], xf[..., half:ROPE_DIM], xf[..., ROPE_DIM:]
    c, s_ = cos[None, :, None, :], sin[None, :, None, :]
    out = jnp.concatenate([x1 * c - x2 * s_, x1 * s_ + x2 * c, rest], axis=-1)
    return out.astype(x.dtype)


def _dilated_branch(q, k, v, window, dilation):
    b, s, h, dh = q.shape
    w = window // dilation
    l = s // dilation
    nb = -(-l // w)
    lp = nb * w
    bb = b * dilation

    def to_sub(t):
        t = t.reshape(b, l, dilation, h, dh).transpose(0, 2, 1, 3, 4).reshape(bb, l, h, dh)
        return jnp.pad(t, ((0, 0), (0, lp - l), (0, 0), (0, 0)))

    def windows(t):
        t = jnp.pad(t, ((0, 0), (w, 0), (0, 0), (0, 0))).reshape(bb, nb + 1, w, h, dh)
        return jnp.concatenate([t[:, :-1], t[:, 1:]], axis=2)

    qb = to_sub(q).reshape(bb, nb, w, h, dh)
    kw, vw = windows(to_sub(k)), windows(to_sub(v))
    scores = jnp.einsum('bnqhd,bnkhd->bnhqk', qb, kw,
                        preferred_element_type=jnp.float32) * (dh ** -0.5)
    qi = jnp.arange(w)[:, None]
    kj = jnp.arange(2 * w)[None, :]
    dist = qi + w - kj
    band = (dist >= 0) & (dist <= w)
    valid = band[None] & ((jnp.arange(nb)[:, None, None] > 0) | (kj >= w)[None])
    scores = jnp.where(valid[None, :, None], scores, NEG_INF)
    m = jnp.max(scores, axis=-1, keepdims=True)
    p = jnp.exp(scores - m)
    den = jnp.sum(p, axis=-1, keepdims=True)
    out = jnp.einsum('bnhqk,bnkhd->bnqhd', p / den, vw.astype(jnp.float32))
    lse = (m + jnp.log(den))[..., 0]
    out = (out.reshape(bb, lp, h, dh)[:, :l]
           .reshape(b, dilation, l, h, dh).transpose(0, 2, 1, 3, 4).reshape(b, s, h, dh))
    lse = (lse.transpose(0, 1, 3, 2).reshape(bb, lp, h)[:, :l]
           .reshape(b, dilation, l, h).transpose(0, 2, 1, 3).reshape(b, s, h))
    return out, lse


def _dilated_attention(q, k, v):
    outs, lses = [], []
    for window, dilation in DILATED_PATTERNS:
        o, lse = _dilated_branch(q, k, v, window, dilation)
        outs.append(o)
        lses.append(lse)
    wts = jax.nn.softmax(jnp.stack(lses), axis=0)
    return jnp.einsum('pbsh,pbshd->bshd', wts, jnp.stack(outs))


def _hgrn2(q, f_pre, inp, lb):
    b, s, h, n = q.shape
    dv = inp.shape[-1]
    c = HG_CHUNK
    nc = s // c
    lb = lb.reshape(h, n).astype(jnp.float32)
    f = lb + (1.0 - lb) * jax.nn.sigmoid(f_pre.astype(jnp.float32))
    g = jnp.log(f)
    k = 1.0 - f

    def chunks(t):
        return t.reshape(b, nc, c, h, t.shape[-1]).transpose(0, 3, 1, 2, 4)

    qc, kc, gc, vc = chunks(q.astype(jnp.float32)), chunks(k), chunks(g), chunks(inp.astype(jnp.float32))
    G = jnp.cumsum(gc, axis=3)
    G_last = G[:, :, :, -1:]
    q_dec = qc * jnp.exp(G)
    att = jnp.einsum('bhntk,bhnsk->bhnts', q_dec, kc * jnp.exp(-G))
    att = jnp.where(jnp.tril(jnp.ones((c, c), dtype=bool)), att, 0.0)
    intra = jnp.einsum('bhnts,bhnsv->bhntv', att, vc)
    chunk_state = jnp.einsum('bhnsk,bhnsv->bhnkv', kc * jnp.exp(G_last - G), vc)
    decay = jnp.exp(G_last[:, :, :, 0])

    def step(state, xs):
        dec, upd = xs
        return dec[..., None] * state + upd, state

    _, prev = lax.scan(step, jnp.zeros((b, h, n, dv), jnp.float32),
                       (jnp.moveaxis(decay, 2, 0), jnp.moveaxis(chunk_state, 2, 0)))
    prev = jnp.moveaxis(prev, 0, 2)
    inter = jnp.einsum('bhntk,bhnkv->bhntv', q_dec, prev)
    return (intra + inter).transpose(0, 2, 3, 1, 4).reshape(b, s, h, dv)


def setup_inputs(seed: int = 0) -> dict:
    key = jax.random.key(seed)
    ks = jax.random.split(key, 20)
    f32 = jnp.float32

    def nrm(k, shape, fan_in):
        return jax.random.normal(k, shape, f32) * (fan_in ** -0.5)

    def gain(k, shape):
        return 1.0 + 0.02 * jax.random.normal(k, shape, f32)

    return {
        'x': jax.random.normal(ks[0], (BATCH, SEQ, D_MODEL), f32),
        'ffn1_norm': gain(ks[1], (DEPTH, D_MODEL)),
        'ffn1_w1': nrm(ks[2], (DEPTH, D_MODEL, D_FF), D_MODEL),
        'ffn1_w3': nrm(ks[3], (DEPTH, D_MODEL, D_FF), D_MODEL),
        'ffn1_w2': nrm(ks[4], (DEPTH, D_FF, D_MODEL), D_FF),
        'mix_norm': gain(ks[5], (DEPTH, D_MODEL)),
        'w_in': nrm(ks[6], (DEPTH, D_MODEL, IN_COLS), D_MODEL),
        'q_norm': gain(ks[7], (DEPTH, HEAD_DIM)),
        'k_norm': gain(ks[8], (DEPTH, HEAD_DIM)),
        'hg_lb_logits': 0.1 * jax.random.normal(ks[9], (DEPTH + 1, HG_KDIM), f32),
        'hg_out_norm': gain(ks[10], (DEPTH, HG_VDIM)),
        'w_out': nrm(ks[11], (DEPTH, MIX_WIDTH, D_MODEL), MIX_WIDTH),
        'ffn2_norm': gain(ks[12], (DEPTH, D_MODEL)),
        'ffn2_w1': nrm(ks[13], (DEPTH, D_MODEL, D_FF), D_MODEL),
        'ffn2_w3': nrm(ks[14], (DEPTH, D_MODEL, D_FF), D_MODEL),
        'ffn2_w2': nrm(ks[15], (DEPTH, D_FF, D_MODEL), D_FF),
    }


def reference(x, ffn1_norm, ffn1_w1, ffn1_w3, ffn1_w2, mix_norm, w_in, q_norm, k_norm,
              hg_lb_logits, hg_out_norm, w_out, ffn2_norm, ffn2_w1, ffn2_w3, ffn2_w2):
    b, s, _ = x.shape
    cos, sin = _rope_tables(s)
    lower_bounds = jnp.cumsum(jax.nn.softmax(hg_lb_logits.astype(jnp.float32), axis=0), axis=0)
    split_at = list(np.cumsum(IN_SIZES)[:-1])
    for layer in range(DEPTH):
        x = x + 0.5 * _swiglu(_rms_norm(x, ffn1_norm[layer]),
                              ffn1_w1[layer], ffn1_w3[layer], ffn1_w2[layer])
        h = _rms_norm(x, mix_norm[layer])
        proj = h @ w_in[layer]
        aq, ak, av, hq, hf, hi, hg = jnp.split(proj, split_at, axis=-1)
        aq = _partial_rope(_rms_norm(aq.reshape(b, s, ATTN_HEADS, HEAD_DIM), q_norm[layer]), cos, sin)
        ak = _partial_rope(_rms_norm(ak.reshape(b, s, ATTN_HEADS, HEAD_DIM), k_norm[layer]), cos, sin)
        av = av.reshape(b, s, ATTN_HEADS, HEAD_DIM)
        attn_out = _dilated_attention(aq, ak, av).astype(x.dtype).reshape(b, s, ATTN_WIDTH)
        rec = _hgrn2(hq.reshape(b, s, HG_HEADS, HG_EXPAND), hf.reshape(b, s, HG_HEADS, HG_EXPAND),
                     hi.reshape(b, s, HG_HEADS, HG_VDIM), lower_bounds[layer]).astype(x.dtype)
        rec = _rms_norm(rec, hg_out_norm[layer]) * jax.nn.silu(hg.reshape(b, s, HG_HEADS, HG_VDIM))
        mixed = jnp.concatenate([attn_out, rec.reshape(b, s, HG_WIDTH)], axis=-1)
        x = x + mixed @ w_out[layer]
        x = x + 0.5 * _swiglu(_rms_norm(x, ffn2_norm[layer]),
                              ffn2_w1[layer], ffn2_w3[layer], ffn2_w2[layer])
    return x
```

```cpp
#include <hip/hip_runtime.h>
#include <hip/hip_cooperative_groups.h>
#include <cstdio>
namespace cg = cooperative_groups;

#define LAS __attribute__((address_space(3)))
#define DI __device__ __forceinline__
typedef unsigned short bf16_t;
typedef short bf16x8 __attribute__((ext_vector_type(8)));
typedef short s16x4 __attribute__((ext_vector_type(4)));
typedef float f32x4 __attribute__((ext_vector_type(4)));
typedef float f32x2 __attribute__((ext_vector_type(2)));
typedef unsigned u32x4 __attribute__((ext_vector_type(4)));
typedef unsigned u32x2 __attribute__((ext_vector_type(2)));
typedef __bf16 bf2_t __attribute__((ext_vector_type(2)));

constexpr int MTOK = 32768, DM = 1024, DFF = 2816, SEQ = 2048, INC = 3584;
constexpr float EPS = 1e-6f;
constexpr size_t SZ_W13 = (size_t)2 * DFF * DM * 2, SZ_W2 = (size_t)DM * DFF * 2, SZ_WIN = (size_t)INC * DM * 2, SZ_WOUT = (size_t)DM * DM * 2;
constexpr size_t OFF_W13A = 0, OFF_W2A = OFF_W13A + SZ_W13, OFF_WIN = OFF_W2A + SZ_W2, OFF_WOUT = OFF_WIN + SZ_WIN, OFF_W13B = OFF_WOUT + SZ_WOUT, OFF_W2B = OFF_W13B + SZ_W13;
constexpr size_t OFF_ROPE = OFF_W2B + SZ_W2;
constexpr size_t OFF_LB = OFF_ROPE + (size_t)SEQ * 16 * 4;
constexpr size_t OFF_HN = OFF_LB + 4096;
constexpr size_t OFF_BIG = OFF_HN + (size_t)MTOK * DM * 2;
constexpr size_t SZ_P = (size_t)MTOK * 512 * 2;
constexpr size_t OFF_Q = OFF_BIG, OFF_K = OFF_Q + SZ_P, OFF_V = OFF_K + SZ_P, OFF_HQ = OFF_V + SZ_P, OFF_HI = OFF_HQ + SZ_P, OFF_HGT = OFF_HI + SZ_P, OFF_G = OFF_HGT + SZ_P;
constexpr size_t OFF_AST = OFF_G + (size_t)MTOK * 512 * 4;
constexpr size_t OFF_AML = OFF_AST + (size_t)128 * SEQ * 64 * 4;
constexpr size_t WS_END = OFF_AML + (size_t)128 * SEQ * 2 * 4;
constexpr int LDS_BYTES = 131072;

struct Params {
    const float* x; const float* ffn1_norm; const float* ffn1_w1; const float* ffn1_w3; const float* ffn1_w2; const float* mix_norm; const float* w_in;
    const float* q_norm; const float* k_norm; const float* lb_logits; const float* hg_out_norm; const float* w_out; const float* ffn2_norm;
    const float* ffn2_w1; const float* ffn2_w3; const float* ffn2_w2;
    float* out; unsigned char* ws;
};

DI unsigned pk2(float lo, float hi) { f32x2 v = {lo, hi}; bf2_t r = __builtin_convertvector(v, bf2_t); return __builtin_bit_cast(unsigned, r); }
DI float bf2f(unsigned short b) { return __uint_as_float(((unsigned)b) << 16); }
DI float sigmoidf_(float v) { return __builtin_amdgcn_rcpf(1.0f + __expf(-v)); }
DI float siluf_(float v) { return v * sigmoidf_(v); }
__host__ __device__ DI int perm32(int rho) { const int n = rho >> 4, i = rho & 15; return 8 * (i >> 2) + 4 * n + (i & 3); }

namespace pg8 {
constexpr int BM = 256, BK = 64, HALF = 128, HTB = HALF * BK * 2, NXCD = 8, WGM = 8;
__host__ __device__ DI int lds_byte(int r, int c) { const int st = (r >> 4) * 2 + (c >> 5), rr = r & 15, cc = c & 31, ob = rr * 64 + cc * 2; return st * 1024 + (ob ^ (((ob >> 9) & 1) << 5)); }
__host__ __device__ DI void stage_rc(int b, int& R, int& C) { const int st = b / 1024, sb = b % 1024, swz = sb ^ (((sb >> 9) & 1) << 5); R = (st >> 1) * 16 + swz / 64; C = (st & 1) * 32 + (swz % 64) / 2; }
struct Unit { int pm, pn; };
struct Gemm { const bf16_t* A; const bf16_t* Bt; int M, N, K; };
struct StaticOrder {
    int nM, nN, nwg, G, c;
    DI void init(int M, int N, int G_, int c_) { nM = M / BM; nN = N / BM; nwg = nM * nN; G = G_; c = c_; }
    DI bool next(int i, Unit& u) const {
        const long L = (long)i * G + c; if (L >= nwg) return false;
        int wgid = (int)L; { const int q = nwg / NXCD, r = nwg % NXCD, xcd = wgid % NXCD, off = wgid / NXCD; wgid = (xcd < r ? xcd * (q + 1) : r * (q + 1) + (xcd - r) * q) + off; }
        const int nig = WGM * nN, gid = wgid / nig, fm = gid * WGM, gsz = (nM - fm) < WGM ? (nM - fm) : WGM;
        u.pm = fm + ((wgid % nig) % gsz); u.pn = (wgid % nig) / gsz; return true;
    }
};

template <class Epi>
DI void gemm_phase(LAS unsigned char* lds, const Gemm g, const StaticOrder& S, const Epi& E) {
    const int tid = threadIdx.x, wid = __builtin_amdgcn_readfirstlane(tid >> 6), lane = tid & 63, wr = wid >> 2, wc = wid & 3, fr = lane & 15, fq = lane >> 4;
    const int K = g.K, nt = K / BK;
    unsigned voffA[2];
#pragma unroll
    for (int i = 0; i < 2; ++i) { int R, C; stage_rc(tid * 16 + i * 8192, R, C); voffA[i] = (unsigned)(R * K + C) * 2u; }
    const size_t kstep = (size_t)(BK * 2);
    const size_t hstep = (size_t)HALF * K * 2;
    const size_t tstep = 2 * hstep;
    const unsigned ldsw = (unsigned)wid * 1024u;
    const int aoff = lds_byte(wr * 64 + fr, fq * 8), boff = lds_byte(wc * 32 + fr, fq * 8);
#define PG8_SA(b, h) (((b) * 2 + (h)) * HTB)
#define PG8_SB(b, h) ((4 + (b) * 2 + (h)) * HTB)
#define PG8_STAGE(bufoff, gbase) do { _Pragma("unroll") for (int _i = 0; _i < 2; ++_i) \
        __builtin_amdgcn_global_load_lds((const unsigned*)((const char*)(gbase) + voffA[_i]), (LAS unsigned*)(lds + (bufoff) + ldsw + _i * 8192), 16, 0, 0); } while (0)
#define PG8_LDA(dst, b, h) do { _Pragma("unroll") for (int m = 0; m < 4; ++m) _Pragma("unroll") for (int k = 0; k < 2; ++k) dst[m][k] = *(const LAS bf16x8*)(lds + PG8_SA(b, h) + aoff + m * 2048 + k * 1024); } while (0)
#define PG8_LDB(dst, b, h) do { _Pragma("unroll") for (int n = 0; n < 2; ++n) _Pragma("unroll") for (int k = 0; k < 2; ++k) dst[n][k] = *(const LAS bf16x8*)(lds + PG8_SB(b, h) + boff + n * 2048 + k * 1024); } while (0)
#define PG8_MMA(ai, bj, At, Bt) do { __builtin_amdgcn_s_setprio(1); _Pragma("unroll") for (int m = 0; m < 4; ++m) _Pragma("unroll") for (int n = 0; n < 2; ++n) _Pragma("unroll") for (int k = 0; k < 2; ++k) \
        acc[ai][bj][m][n] = __builtin_amdgcn_mfma_f32_16x16x32_bf16(Bt[n][k], At[m][k], acc[ai][bj][m][n], 0, 0, 0); __builtin_amdgcn_s_setprio(0); } while (0)
#define PG8_WAIT_V(n) asm volatile("s_waitcnt vmcnt(" #n ")" ::: "memory")
#define PG8_WAIT_L(n) asm volatile("s_waitcnt lgkmcnt(" #n ")" ::: "memory")
#define PG8_BAR __builtin_amdgcn_s_barrier()
#define PG8_SCHED __builtin_amdgcn_sched_barrier(0)
    Unit cur, nxt; int ui = 0;
    if (!S.next(0, cur)) return;
    f32x4 acc[2][2][4][2];
#pragma unroll
    for (int a = 0; a < 2; ++a)
#pragma unroll
        for (int b = 0; b < 2; ++b)
#pragma unroll
            for (int m = 0; m < 4; ++m)
#pragma unroll
                for (int n = 0; n < 2; ++n) acc[a][b][m][n] = (f32x4){0.f, 0.f, 0.f, 0.f};
    bf16x8 At[4][2], B0[2][2], B1[2][2];
    const char* cA = (const char*)g.A + (size_t)cur.pm * tstep; const char* cB = (const char*)g.Bt + (size_t)cur.pn * tstep;
    PG8_STAGE(PG8_SB(0, 0), cB); PG8_STAGE(PG8_SA(0, 0), cA); PG8_STAGE(PG8_SB(0, 1), cB + hstep); PG8_STAGE(PG8_SA(0, 1), cA + hstep);
    if (wr == 1) PG8_BAR;
    PG8_WAIT_V(4); PG8_BAR;
    PG8_STAGE(PG8_SB(1, 0), cB + kstep); PG8_STAGE(PG8_SA(1, 0), cA + kstep); PG8_STAGE(PG8_SB(1, 1), cB + hstep + kstep);
    PG8_WAIT_V(6); PG8_BAR;
    for (;;) {
        const bool has_next = S.next(ui + 1, nxt);
        const char* nA = has_next ? (const char*)g.A + (size_t)nxt.pm * tstep : cA; const char* nB = has_next ? (const char*)g.Bt + (size_t)nxt.pn * tstep : cB;
        for (int t = 0; t < nt; t += 2) {
            const bool last = (t == nt - 2);
            const char* a1 = cA + (size_t)(t + 1) * kstep;
            const char* a2 = last ? nA : cA + (size_t)(t + 2) * kstep; const char* b2 = last ? nB : cB + (size_t)(t + 2) * kstep;
            const char* a3 = a2 + kstep; const char* b3 = b2 + kstep;
            PG8_LDB(B0, 0, 0); PG8_SCHED; PG8_LDA(At, 0, 0); PG8_STAGE(PG8_SA(1, 1), a1 + hstep);
            PG8_WAIT_L(8); PG8_BAR; PG8_WAIT_L(0); PG8_MMA(0, 0, At, B0); PG8_BAR; PG8_SCHED;
            PG8_LDB(B1, 0, 1); PG8_STAGE(PG8_SB(0, 0), b2);
            PG8_BAR; PG8_WAIT_L(0); PG8_MMA(0, 1, At, B1); PG8_BAR;
            PG8_LDA(At, 0, 1); PG8_STAGE(PG8_SA(0, 0), a2);
            PG8_BAR; PG8_WAIT_L(0); PG8_MMA(1, 0, At, B0); PG8_BAR; PG8_SCHED;
            PG8_STAGE(PG8_SB(0, 1), b2 + hstep);
            PG8_WAIT_V(6); PG8_BAR; PG8_MMA(1, 1, At, B1); PG8_BAR;
            PG8_LDB(B0, 1, 0); PG8_SCHED; PG8_LDA(At, 1, 0); PG8_STAGE(PG8_SA(0, 1), a2 + hstep);
            PG8_WAIT_L(8); PG8_BAR; PG8_WAIT_L(0); PG8_MMA(0, 0, At, B0); PG8_BAR; PG8_SCHED;
            PG8_LDB(B1, 1, 1); PG8_STAGE(PG8_SB(1, 0), b3);
            PG8_BAR; PG8_WAIT_L(0); PG8_MMA(0, 1, At, B1); PG8_BAR;
            PG8_LDA(At, 1, 1); PG8_STAGE(PG8_SA(1, 0), a3);
            PG8_BAR; PG8_WAIT_L(0); PG8_MMA(1, 0, At, B0); PG8_BAR; PG8_SCHED;
            PG8_STAGE(PG8_SB(1, 1), b3 + hstep);
            PG8_WAIT_V(6); PG8_BAR; PG8_MMA(1, 1, At, B1); PG8_BAR;
        }
        E(acc, cur, wr, wc, fr, fq);
        if (!has_next) break;
#pragma unroll
        for (int a = 0; a < 2; ++a)
#pragma unroll
            for (int b = 0; b < 2; ++b)
#pragma unroll
                for (int m = 0; m < 4; ++m)
#pragma unroll
                    for (int n = 0; n < 2; ++n) acc[a][b][m][n] = (f32x4){0.f, 0.f, 0.f, 0.f};
        cur = nxt; cA = nA; cB = nB; ++ui;
    }
    PG8_WAIT_V(0);
    if (wr == 0) PG8_BAR;
    PG8_BAR;
#undef PG8_SA
#undef PG8_SB
#undef PG8_STAGE
#undef PG8_LDA
#undef PG8_LDB
#undef PG8_MMA
#undef PG8_WAIT_V
#undef PG8_WAIT_L
#undef PG8_BAR
#undef PG8_SCHED
}
}
using pg8::Unit;
typedef f32x4 AccT[2][2][4][2];

struct EpiSwiGLU {
    bf16_t* U;
    DI void operator()(const AccT& acc, const Unit& u, int wr, int wc, int fr, int fq) const {
        const int row0 = u.pm * 256 + wr * 64 + fr, col0 = u.pn * 128 + wc * 32 + 8 * fq;
#pragma unroll
        for (int ai = 0; ai < 2; ++ai)
#pragma unroll
            for (int m = 0; m < 4; ++m) {
                float v[8];
#pragma unroll
                for (int n = 0; n < 2; ++n)
#pragma unroll
                    for (int j = 0; j < 4; ++j) v[4 * n + j] = siluf_(acc[ai][0][m][n][j]) * acc[ai][1][m][n][j];
                u32x4 w; w.x = pk2(v[0], v[1]); w.y = pk2(v[2], v[3]); w.z = pk2(v[4], v[5]); w.w = pk2(v[6], v[7]);
                *(u32x4*)(U + (size_t)(row0 + ai * 128 + m * 16) * DFF + col0) = w;
            }
    }
};
struct EpiResid {
    const float* R; float* O; float scale;
    DI void operator()(const AccT& acc, const Unit& u, int wr, int wc, int fr, int fq) const {
        const int row0 = u.pm * 256 + wr * 64 + fr, col0 = u.pn * 256 + wc * 32 + 4 * fq;
#pragma unroll
        for (int ai = 0; ai < 2; ++ai)
#pragma unroll
            for (int m = 0; m < 4; ++m) {
                const size_t ro = (size_t)(row0 + ai * 128 + m * 16) * DM + col0;
#pragma unroll
                for (int bj = 0; bj < 2; ++bj)
#pragma unroll
                    for (int n = 0; n < 2; ++n) { const f32x4 r = *(const f32x4*)(R + ro + bj * 128 + n * 16); *(f32x4*)(O + ro + bj * 128 + n * 16) = r + acc[ai][bj][m][n] * scale; }
            }
    }
};
struct EpiProj {
    unsigned char* ws; const float* q_norm; const float* k_norm;
    DI void operator()(const AccT& acc, const Unit& u, int wr, int wc, int fr, int fq) const {
        const int sec = u.pn >> 1, cbase = 256 * (u.pn & 1) + 64 * wc + 8 * fq;
        const int row0 = u.pm * 256 + wr * 64 + fr;
        if (sec <= 1) {
            const float* gn = sec == 0 ? q_norm : k_norm;
            bf16_t* dst = (bf16_t*)(ws + (sec == 0 ? OFF_Q : OFF_K));
            const float osc = sec == 0 ? 0.125f : 1.0f;
            f32x4 gv[2][2];
#pragma unroll
            for (int bj = 0; bj < 2; ++bj)
#pragma unroll
                for (int n = 0; n < 2; ++n) gv[bj][n] = *(const f32x4*)(gn + 32 * bj + 8 * fq + 4 * n) * osc;
            const float* rope = (const float*)(ws + OFF_ROPE);
#pragma unroll
            for (int ai = 0; ai < 2; ++ai)
#pragma unroll
                for (int m = 0; m < 4; ++m) {
                    const int row = row0 + ai * 128 + m * 16;
                    float ss = 0.f;
#pragma unroll
                    for (int bj = 0; bj < 2; ++bj)
#pragma unroll
                        for (int n = 0; n < 2; ++n) { const f32x4 a = acc[ai][bj][m][n]; ss += a[0] * a[0] + a[1] * a[1] + a[2] * a[2] + a[3] * a[3]; }
                    ss += __shfl_xor(ss, 16); ss += __shfl_xor(ss, 32);
                    const float rstd = rsqrtf(ss * (1.0f / 64.0f) + EPS);
                    f32x4 y[2][2];
#pragma unroll
                    for (int bj = 0; bj < 2; ++bj)
#pragma unroll
                        for (int n = 0; n < 2; ++n) y[bj][n] = acc[ai][bj][m][n] * rstd * gv[bj][n];
                    const float* rp = rope + (size_t)(row & (SEQ - 1)) * 16;
#pragma unroll
                    for (int n = 0; n < 2; ++n) {
                        const f32x4 cs = *(const f32x4*)(rp + 4 * n), sn = *(const f32x4*)(rp + 8 + 4 * n);
                        f32x4 own = y[0][n], oth;
#pragma unroll
                        for (int j = 0; j < 4; ++j) oth[j] = __shfl_xor(own[j], 16);
                        f32x4 r0 = own * cs - oth * sn;
                        f32x4 r1 = oth * sn + own * cs;
                        y[0][n] = fq == 0 ? r0 : (fq == 1 ? r1 : own);
                    }
#pragma unroll
                    for (int bj = 0; bj < 2; ++bj) {
                        u32x4 w; w.x = pk2(y[bj][0][0], y[bj][0][1]); w.y = pk2(y[bj][0][2], y[bj][0][3]); w.z = pk2(y[bj][1][0], y[bj][1][1]); w.w = pk2(y[bj][1][2], y[bj][1][3]);
                        *(u32x4*)(dst + (size_t)row * 512 + cbase + 32 * bj) = w;
                    }
                }
        } else if (sec == 4) {
            float* dst = (float*)(ws + OFF_G);
            const float* lbt = (const float*)(ws + OFF_LB);
            f32x4 lb[2][2];
#pragma unroll
            for (int bj = 0; bj < 2; ++bj)
#pragma unroll
                for (int n = 0; n < 2; ++n) lb[bj][n] = *(const f32x4*)(lbt + cbase + 32 * bj + 4 * n);
#pragma unroll
            for (int ai = 0; ai < 2; ++ai)
#pragma unroll
                for (int m = 0; m < 4; ++m) {
                    const int row = row0 + ai * 128 + m * 16;
#pragma unroll
                    for (int bj = 0; bj < 2; ++bj)
#pragma unroll
                        for (int n = 0; n < 2; ++n) {
                            f32x4 o;
#pragma unroll
                            for (int j = 0; j < 4; ++j) { const float l = lb[bj][n][j]; o[j] = __logf(l + (1.0f - l) * sigmoidf_(acc[ai][bj][m][n][j])); }
                            *(f32x4*)(dst + (size_t)row * 512 + cbase + 32 * bj + 4 * n) = o;
                        }
                }
        } else {
            bf16_t* dst = (bf16_t*)(ws + (sec == 2 ? OFF_V : sec == 3 ? OFF_HQ : sec == 5 ? OFF_HI : OFF_HGT));
            const bool act = sec == 6;
#pragma unroll
            for (int ai = 0; ai < 2; ++ai)
#pragma unroll
                for (int m = 0; m < 4; ++m) {
                    const int row = row0 + ai * 128 + m * 16;
#pragma unroll
                    for (int bj = 0; bj < 2; ++bj) {
                        f32x4 a = acc[ai][bj][m][0], b = acc[ai][bj][m][1];
                        if (act) {
#pragma unroll
                            for (int j = 0; j < 4; ++j) { a[j] = siluf_(a[j]); b[j] = siluf_(b[j]); }
                        }
                        u32x4 w; w.x = pk2(a[0], a[1]); w.y = pk2(a[2], a[3]); w.z = pk2(b[0], b[1]); w.w = pk2(b[2], b[3]);
                        *(u32x4*)(dst + (size_t)row * 512 + cbase + 32 * bj) = w;
                    }
                }
        }
    }
};

DI void conv_tile(LAS float* t, const float* W, const float* W3, int ncols, bf16_t* Bt, int K, int s0, int k0, int kind) {
    const int tid = threadIdx.x, lane = tid & 63, kq = tid >> 6;
    const int slot = s0 + lane;
    const float* src = W; int col = slot;
    if (kind == 1) { const int pn = slot >> 8, bj = (slot >> 7) & 1, wc = (slot >> 5) & 3, r = slot & 31; src = bj ? W3 : W; col = 128 * pn + 32 * wc + perm32(r); }
    else if (kind == 2) { const int bj = (slot >> 7) & 1, wc = (slot >> 5) & 3, r = slot & 31; col = (slot & ~255) + 64 * wc + 32 * bj + perm32(r); }
    float v[8];
#pragma unroll
    for (int it = 0; it < 8; ++it) v[it] = src[(size_t)(k0 + kq + 8 * it) * ncols + col];
#pragma unroll
    for (int it = 0; it < 8; ++it) t[(kq + 8 * it) * 65 + lane] = v[it];
    __syncthreads();
    const int sl = tid >> 3, kc = tid & 7;
    float o[8];
#pragma unroll
    for (int e = 0; e < 8; ++e) o[e] = t[(8 * kc + e) * 65 + sl];
    u32x4 w; w.x = pk2(o[0], o[1]); w.y = pk2(o[2], o[3]); w.z = pk2(o[4], o[5]); w.w = pk2(o[6], o[7]);
    *(u32x4*)(Bt + (size_t)(s0 + sl) * K + k0 + 8 * kc) = w;
    __syncthreads();
}

DI void norm_rows(const float* X, const float* w, bf16_t* out) {
    const int lane = threadIdx.x & 63, gw = blockIdx.x * 8 + (threadIdx.x >> 6), nw = gridDim.x * 8;
    f32x4 wv[4];
#pragma unroll
    for (int i = 0; i < 4; ++i) wv[i] = *(const f32x4*)(w + 4 * lane + 256 * i);
    for (int row = gw; row < MTOK; row += nw) {
        const float* xr = X + (size_t)row * DM;
        f32x4 v[4]; float ss = 0.f;
#pragma unroll
        for (int i = 0; i < 4; ++i) { v[i] = *(const f32x4*)(xr + 4 * lane + 256 * i); ss += v[i][0] * v[i][0] + v[i][1] * v[i][1] + v[i][2] * v[i][2] + v[i][3] * v[i][3]; }
#pragma unroll
        for (int o = 32; o >= 1; o >>= 1) ss += __shfl_xor(ss, o);
        const float rstd = rsqrtf(ss * (1.0f / DM) + EPS);
#pragma unroll
        for (int i = 0; i < 4; ++i) { const f32x4 y = v[i] * rstd * wv[i]; u32x2 p; p.x = pk2(y[0], y[1]); p.y = pk2(y[2], y[3]); *(u32x2*)(out + (size_t)row * DM + 4 * lane + 256 * i) = p; }
    }
}

DI void phase_prep(const Params& p, LAS unsigned char* lds) {
    LAS float* t = (LAS float*)lds;
    unsigned char* ws = p.ws;
    { const int idx = blockIdx.x * 512 + threadIdx.x;
      if (idx < SEQ * 8) { const int pos = idx >> 3, i = idx & 7; const float inv = powf(500000.0f, -(float)i * 0.125f); const float ang = (float)pos * inv; float* rt = (float*)(ws + OFF_ROPE); rt[pos * 16 + i] = cosf(ang); rt[pos * 16 + 8 + i] = sinf(ang); }
      if (idx < 512) { const float l0 = p.lb_logits[idx], l1 = p.lb_logits[512 + idx]; ((float*)(ws + OFF_LB))[idx] = 1.0f / (1.0f + expf(l1 - l0)); } }
    constexpr int T13 = 88 * 16, T2 = 16 * 44, TIN = 56 * 16, TOUT = 16 * 16, TTOT = 2 * T13 + 2 * T2 + TIN + TOUT;
    for (int ti = blockIdx.x; ti < TTOT; ti += gridDim.x) {
        int r = ti;
        if (r < T13) { conv_tile(t, p.ffn1_w1, p.ffn1_w3, DFF, (bf16_t*)(ws + OFF_W13A), DM, (r >> 4) * 64, (r & 15) * 64, 1); continue; } r -= T13;
        if (r < T2) { conv_tile(t, p.ffn1_w2, nullptr, DM, (bf16_t*)(ws + OFF_W2A), DFF, (r / 44) * 64, (r % 44) * 64, 0); continue; } r -= T2;
        if (r < TIN) { conv_tile(t, p.w_in, nullptr, INC, (bf16_t*)(ws + OFF_WIN), DM, (r >> 4) * 64, (r & 15) * 64, 2); continue; } r -= TIN;
        if (r < TOUT) { conv_tile(t, p.w_out, nullptr, DM, (bf16_t*)(ws + OFF_WOUT), DM, (r >> 4) * 64, (r & 15) * 64, 0); continue; } r -= TOUT;
        if (r < T13) { conv_tile(t, p.ffn2_w1, p.ffn2_w3, DFF, (bf16_t*)(ws + OFF_W13B), DM, (r >> 4) * 64, (r & 15) * 64, 1); continue; } r -= T13;
        conv_tile(t, p.ffn2_w2, nullptr, DM, (bf16_t*)(ws + OFF_W2B), DFF, (r / 44) * 64, (r % 44) * 64, 0);
    }
    norm_rows(p.x, p.ffn1_norm, (bf16_t*)(ws + OFF_HN));
}

constexpr int AROW = 144;
DI void attn_item(const Params& p, LAS unsigned char* lds, int item) {
    const int tid = threadIdx.x, w = __builtin_amdgcn_readfirstlane(tid >> 6), lane = tid & 63, li = lane & 15, g = lane >> 4;
    const int b = item >> 3, h = item & 7;
    unsigned char* ws = p.ws;
    const bf16_t* Qg = (const bf16_t*)(ws + OFF_Q) + (size_t)b * SEQ * 512 + h * 64;
    const bf16_t* Kg = (const bf16_t*)(ws + OFF_K) + (size_t)b * SEQ * 512 + h * 64;
    const bf16_t* Vg = (const bf16_t*)(ws + OFF_V) + (size_t)b * SEQ * 512 + h * 64;
    float* ast = (float*)(ws + OFF_AST) + (size_t)item * SEQ * 64;
    float* aml = (float*)(ws + OFF_AML) + (size_t)item * SEQ * 2;
    bf16_t* mixed = (bf16_t*)(ws + OFF_HN) + (size_t)b * SEQ * DM + h * 64;
    LAS unsigned char* Ks = lds;
    LAS unsigned char* Vs = lds + 256 * AROW;
#pragma unroll 1
    for (int pat = 0; pat < 3; ++pat) {
        const int d = pat == 0 ? 16 : (pat == 1 ? 4 : 1);
        const int nblk = SEQ / d / 128;
#pragma unroll 1
        for (int sp = 0; sp < 16; ++sp) {
            const int res = sp / nblk, blk = sp % nblk, P0 = blk * 128;
            __syncthreads();
#pragma unroll
            for (int i = 0; i < 4; ++i) {
                const int c = tid + 512 * i, row = c >> 3, ch = c & 7;
                const int pp = P0 - 128 + row;
                u32x4 kv = {0u, 0u, 0u, 0u}, vv = {0u, 0u, 0u, 0u};
                if (pp >= 0) { const size_t off = (size_t)(res + d * pp) * 512 + 8 * ch; kv = *(const u32x4*)(Kg + off); vv = *(const u32x4*)(Vg + off); }
                *(LAS u32x4*)(Ks + row * AROW + 16 * ch) = kv;
                *(LAS u32x4*)(Vs + row * AROW + 16 * ch) = vv;
            }
            __syncthreads();
            const int tq = res + d * (P0 + 16 * w + li);
            const bf16x8 qf0 = *(const bf16x8*)(Qg + (size_t)tq * 512 + 8 * g), qf1 = *(const bf16x8*)(Qg + (size_t)tq * 512 + 32 + 8 * g);
            const int kt_lo = blk == 0 ? (8 - w) : 0;
            f32x4 s[9];
#pragma unroll
            for (int kt = 0; kt < 9; ++kt) {
                if (kt >= kt_lo) {
                    const LAS unsigned char* kr = Ks + (16 * (w + kt) + li) * AROW + 16 * g;
                    const bf16x8 kf0 = *(const LAS bf16x8*)kr, kf1 = *(const LAS bf16x8*)(kr + 64);
                    f32x4 c = {0.f, 0.f, 0.f, 0.f};
                    c = __builtin_amdgcn_mfma_f32_16x16x32_bf16(kf0, qf0, c, 0, 0, 0);
                    c = __builtin_amdgcn_mfma_f32_16x16x32_bf16(kf1, qf1, c, 0, 0, 0);
                    s[kt] = c;
                } else s[kt] = (f32x4){-1e30f, -1e30f, -1e30f, -1e30f};
            }
#pragma unroll
            for (int j = 0; j < 4; ++j) { if (4 * g + j < li) s[0][j] = -1e30f; if (4 * g + j > li) s[8][j] = -1e30f; }
            float mx = -1e30f;
#pragma unroll
            for (int kt = 0; kt < 9; ++kt)
#pragma unroll
                for (int j = 0; j < 4; ++j) mx = fmaxf(mx, s[kt][j]);
            mx = fmaxf(mx, __shfl_xor(mx, 16)); mx = fmaxf(mx, __shfl_xor(mx, 32));
            float ls = 0.f;
#pragma unroll
            for (int kt = 0; kt < 9; ++kt)
#pragma unroll
                for (int j = 0; j < 4; ++j) { const float e = __expf(s[kt][j] - mx); s[kt][j] = e; ls += e; }
            ls += __shfl_xor(ls, 16); ls += __shfl_xor(ls, 32);
            f32x4 o[4];
#pragma unroll
            for (int dt = 0; dt < 4; ++dt) o[dt] = (f32x4){0.f, 0.f, 0.f, 0.f};
#pragma unroll
            for (int c = 0; c < 5; ++c) {
                if (2 * c + 1 >= kt_lo || c == 4) {
                    u32x4 pw; pw.x = pk2(s[2 * c][0], s[2 * c][1]); pw.y = pk2(s[2 * c][2], s[2 * c][3]);
                    if (c < 4) { pw.z = pk2(s[2 * c + 1][0], s[2 * c + 1][1]); pw.w = pk2(s[2 * c + 1][2], s[2 * c + 1][3]); } else { pw.z = 0u; pw.w = 0u; }
                    const bf16x8 pf = __builtin_bit_cast(bf16x8, pw);
                    const LAS unsigned char* vr = Vs + (16 * (w + 2 * c) + 4 * g + (li >> 2)) * AROW + 8 * (li & 3);
#pragma unroll
                    for (int dt = 0; dt < 4; ++dt) {
                        const s16x4 t0 = __builtin_amdgcn_ds_read_tr16_b64_v4i16((LAS s16x4*)(vr + 32 * dt));
                        s16x4 t1 = {0, 0, 0, 0};
                        if (c < 4) t1 = __builtin_amdgcn_ds_read_tr16_b64_v4i16((LAS s16x4*)(vr + 16 * AROW + 32 * dt));
                        const bf16x8 vf = {t0[0], t0[1], t0[2], t0[3], t1[0], t1[1], t1[2], t1[3]};
                        o[dt] = __builtin_amdgcn_mfma_f32_16x16x32_bf16(vf, pf, o[dt], 0, 0, 0);
                    }
                }
            }
            float* sa = ast + (size_t)tq * 64 + 4 * g;
            float* sm = aml + (size_t)tq * 2;
            if (pat > 0) {
                const float mo = sm[0], lo = sm[1];
                const float mn = fmaxf(mo, mx), a = __expf(mo - mn), bb = __expf(mx - mn);
#pragma unroll
                for (int dt = 0; dt < 4; ++dt) { const f32x4 old = *(const f32x4*)(sa + 16 * dt); o[dt] = old * a + o[dt] * bb; }
                ls = lo * a + ls * bb; mx = mn;
            }
            if (pat < 2) {
#pragma unroll
                for (int dt = 0; dt < 4; ++dt) *(f32x4*)(sa + 16 * dt) = o[dt];
                if (g == 0) { sm[0] = mx; sm[1] = ls; }
            } else {
                const float il = 1.0f / ls;
#pragma unroll
                for (int dt = 0; dt < 4; ++dt) { u32x2 pw; pw.x = pk2(o[dt][0] * il, o[dt][1] * il); pw.y = pk2(o[dt][2] * il, o[dt][3] * il); *(u32x2*)(mixed + (size_t)tq * DM + 16 * dt + 4 * g) = pw; }
            }
        }
    }
    __syncthreads();
}

constexpr int H_QD = 0, H_KD = 17408, H_KLT = 34816, H_VS = 53248, H_ATT = 70656, H_DEC = 79872, H_CS = 80384, H_SSQ = 82432;
DI void hgrn_item(const Params& p, LAS unsigned char* lds, int item) {
    const int tid = threadIdx.x, w = __builtin_amdgcn_readfirstlane(tid >> 6), lane = tid & 63, li = lane & 15, g = lane >> 4;
    const int b = item >> 2, h = item & 3, cb = h * 128;
    unsigned char* ws = p.ws;
    const bf16_t* HQ = (const bf16_t*)(ws + OFF_HQ) + (size_t)b * SEQ * 512 + cb;
    const bf16_t* HI = (const bf16_t*)(ws + OFF_HI) + (size_t)b * SEQ * 512 + cb;
    const bf16_t* HG = (const bf16_t*)(ws + OFF_HGT) + (size_t)b * SEQ * 512 + cb;
    const float* GG = (const float*)(ws + OFF_G) + (size_t)b * SEQ * 512 + cb;
    bf16_t* mixed = (bf16_t*)(ws + OFF_HN) + (size_t)b * SEQ * DM + 512 + cb;
    LAS float* CS = (LAS float*)(lds + H_CS);
    LAS float* DEC = (LAS float*)(lds + H_DEC);
    LAS float* SSQ = (LAS float*)(lds + H_SSQ);
    f32x4 St[8];
#pragma unroll
    for (int kt = 0; kt < 8; ++kt) St[kt] = (f32x4){0.f, 0.f, 0.f, 0.f};
    const f32x4 gain = *(const f32x4*)(p.hg_out_norm + 16 * w + 4 * g);
    const int k = tid & 127, tqq = tid >> 7;
#pragma unroll 1
    for (int n = 0; n < 32; ++n) {
        const int t0 = n * 64;
        {
            float gc[16], qv[16];
#pragma unroll
            for (int e = 0; e < 16; ++e) { const size_t o = (size_t)(t0 + 16 * tqq + e) * 512 + k; gc[e] = GG[o]; qv[e] = bf2f(HQ[o]); }
            float kk[16];
#pragma unroll
            for (int e = 0; e < 16; ++e) kk[e] = 1.0f - __expf(gc[e]);
#pragma unroll
            for (int e = 1; e < 16; ++e) gc[e] += gc[e - 1];
            CS[tqq * 128 + k] = gc[15];
#pragma unroll
            for (int i = 0; i < 2; ++i) { const int c = tid + 512 * i, row = c >> 4, ch = c & 15; *(LAS u32x4*)(lds + H_VS + row * 272 + 16 * ch) = *(const u32x4*)(HI + (size_t)(t0 + row) * 512 + 8 * ch); }
            __syncthreads();
            const float c0 = CS[k], c1 = CS[128 + k], c2 = CS[256 + k], c3 = CS[384 + k];
            const float off = tqq == 0 ? 0.f : (tqq == 1 ? c0 : (tqq == 2 ? c0 + c1 : c0 + c1 + c2));
            const float gl = c0 + c1 + c2 + c3;
            if (tqq == 0) DEC[k] = __expf(gl);
            unsigned klp[8];
            float klprev = 0.f;
#pragma unroll
            for (int e = 0; e < 16; ++e) {
                const float G = off + gc[e];
                const float qd = qv[e] * __expf(G), kd = kk[e] * __expf(-G), kl = kk[e] * __expf(gl - G);
                const int t = 16 * tqq + e;
                *(LAS bf16_t*)(lds + H_QD + t * 272 + 2 * k) = (bf16_t)(pk2(qd, 0.f) & 0xffffu);
                *(LAS bf16_t*)(lds + H_KD + t * 272 + 2 * k) = (bf16_t)(pk2(kd, 0.f) & 0xffffu);
                if (e & 1) klp[e >> 1] = pk2(klprev, kl); else klprev = kl;
            }
            *(LAS u32x4*)(lds + H_KLT + k * 144 + 32 * tqq) = (u32x4){klp[0], klp[1], klp[2], klp[3]};
            *(LAS u32x4*)(lds + H_KLT + k * 144 + 32 * tqq + 16) = (u32x4){klp[4], klp[5], klp[6], klp[7]};
        }
        __syncthreads();
        {
            const int ti = w >> 1;
#pragma unroll
            for (int q = 0; q < 2; ++q) {
                const int si = 2 * (w & 1) + q;
                f32x4 c = {0.f, 0.f, 0.f, 0.f};
                if (si <= ti) {
#pragma unroll
                    for (int kc = 0; kc < 4; ++kc) {
                        const bf16x8 a = *(const LAS bf16x8*)(lds + H_KD + (16 * si + li) * 272 + 64 * kc + 16 * g);
                        const bf16x8 bq = *(const LAS bf16x8*)(lds + H_QD + (16 * ti + li) * 272 + 64 * kc + 16 * g);
                        c = __builtin_amdgcn_mfma_f32_16x16x32_bf16(a, bq, c, 0, 0, 0);
                    }
                    if (si == ti) {
#pragma unroll
                        for (int j = 0; j < 4; ++j) if (4 * g + j > li) c[j] = 0.f;
                    }
                }
                u32x2 pw; pw.x = pk2(c[0], c[1]); pw.y = pk2(c[2], c[3]);
                *(LAS u32x2*)(lds + H_ATT + (16 * ti + li) * 144 + 32 * si + 8 * g) = pw;
            }
        }
        __syncthreads();
        f32x4 o[4];
        {
            bf16x8 vf[2];
#pragma unroll
            for (int tc = 0; tc < 2; ++tc) {
                const LAS unsigned char* vr = lds + H_VS + (32 * tc + 8 * g + (li >> 2)) * 272 + 32 * w + 8 * (li & 3);
                const s16x4 a0 = __builtin_amdgcn_ds_read_tr16_b64_v4i16((LAS s16x4*)vr);
                const s16x4 a1 = __builtin_amdgcn_ds_read_tr16_b64_v4i16((LAS s16x4*)(vr + 4 * 272));
                vf[tc] = (bf16x8){a0[0], a0[1], a0[2], a0[3], a1[0], a1[1], a1[2], a1[3]};
            }
            bf16x8 sf[4];
#pragma unroll
            for (int pr = 0; pr < 4; ++pr) {
                u32x4 pw; pw.x = pk2(St[2 * pr][0], St[2 * pr][1]); pw.y = pk2(St[2 * pr][2], St[2 * pr][3]); pw.z = pk2(St[2 * pr + 1][0], St[2 * pr + 1][1]); pw.w = pk2(St[2 * pr + 1][2], St[2 * pr + 1][3]);
                sf[pr] = __builtin_bit_cast(bf16x8, pw);
            }
#pragma unroll
            for (int tt = 0; tt < 4; ++tt) {
                f32x4 c = {0.f, 0.f, 0.f, 0.f};
#pragma unroll
                for (int sc = 0; sc < 2; ++sc) {
                    const bf16x8 af = *(const LAS bf16x8*)(lds + H_ATT + (16 * tt + li) * 144 + 64 * sc + 16 * g);
                    c = __builtin_amdgcn_mfma_f32_16x16x32_bf16(vf[sc], af, c, 0, 0, 0);
                }
#pragma unroll
                for (int pr = 0; pr < 4; ++pr) {
                    const LAS unsigned char* qr = lds + H_QD + (16 * tt + li) * 272 + 64 * pr + 8 * g;
                    const u32x2 q0 = *(const LAS u32x2*)qr, q1 = *(const LAS u32x2*)(qr + 32);
                    const bf16x8 qf = __builtin_bit_cast(bf16x8, ((u32x4){q0.x, q0.y, q1.x, q1.y}));
                    c = __builtin_amdgcn_mfma_f32_16x16x32_bf16(sf[pr], qf, c, 0, 0, 0);
                }
                o[tt] = c;
            }
#pragma unroll
            for (int kt = 0; kt < 8; ++kt) {
                const f32x4 dec = *(const LAS f32x4*)(DEC + 16 * kt + 4 * g);
                f32x4 c = St[kt] * dec;
#pragma unroll
                for (int tc = 0; tc < 2; ++tc) {
                    const bf16x8 kf = *(const LAS bf16x8*)(lds + H_KLT + (16 * kt + li) * 144 + 64 * tc + 16 * g);
                    c = __builtin_amdgcn_mfma_f32_16x16x32_bf16(kf, vf[tc], c, 0, 0, 0);
                }
                St[kt] = c;
            }
#pragma unroll
            for (int tt = 0; tt < 4; ++tt) {
                float ss = o[tt][0] * o[tt][0] + o[tt][1] * o[tt][1] + o[tt][2] * o[tt][2] + o[tt][3] * o[tt][3];
                ss += __shfl_xor(ss, 16); ss += __shfl_xor(ss, 32);
                if (g == 0) SSQ[(16 * tt + li) * 8 + w] = ss;
            }
        }
        __syncthreads();
#pragma unroll
        for (int tt = 0; tt < 4; ++tt) {
            const int t = 16 * tt + li;
            const f32x4 s0 = *(const LAS f32x4*)(SSQ + t * 8), s1 = *(const LAS f32x4*)(SSQ + t * 8 + 4);
            const float tot = (s0[0] + s0[1]) + (s0[2] + s0[3]) + (s1[0] + s1[1]) + (s1[2] + s1[3]);
            const float rstd = rsqrtf(tot * (1.0f / 128.0f) + EPS);
            const u32x2 gw = *(const u32x2*)(HG + (size_t)(t0 + t) * 512 + 16 * w + 4 * g);
            const float g0 = __uint_as_float(gw.x << 16), g1 = __uint_as_float(gw.x & 0xffff0000u), g2 = __uint_as_float(gw.y << 16), g3 = __uint_as_float(gw.y & 0xffff0000u);
            u32x2 pw; pw.x = pk2(o[tt][0] * rstd * gain[0] * g0, o[tt][1] * rstd * gain[1] * g1); pw.y = pk2(o[tt][2] * rstd * gain[2] * g2, o[tt][3] * rstd * gain[3] * g3);
            *(u32x2*)(mixed + (size_t)(t0 + t) * DM + 16 * w + 4 * g) = pw;
        }
    }
    __syncthreads();
}

constexpr int NPHASE = 10;
#ifndef PHASE_MASK
#define PHASE_MASK 0xfff
#endif
#define PH_ON(n) ((PHASE_MASK >> (n)) & 1)
__global__ void __launch_bounds__(512, 2) hymba_fwd(Params p, int ph_lo, int ph_hi) {
    extern __shared__ __attribute__((aligned(16))) unsigned char shm[];
    LAS unsigned char* lds = (LAS unsigned char*)shm;
    unsigned char* ws = p.ws;
    pg8::StaticOrder S;
#define SEAM(n) if (ph_lo <= (n) && (n) + 1 < ph_hi) cg::this_grid().sync();
#define RUNS(n) (PH_ON(n) && ph_lo <= (n) && (n) < ph_hi)
    if (RUNS(0)) phase_prep(p, lds);
    SEAM(0)
    if (RUNS(1)) { S.init(MTOK, 2 * DFF, gridDim.x, blockIdx.x); pg8::Gemm g{(const bf16_t*)(ws + OFF_HN), (const bf16_t*)(ws + OFF_W13A), MTOK, 2 * DFF, DM}; EpiSwiGLU e{(bf16_t*)(ws + OFF_BIG)}; pg8::gemm_phase(lds, g, S, e); }
    SEAM(1)
    if (RUNS(2)) { S.init(MTOK, DM, gridDim.x, blockIdx.x); pg8::Gemm g{(const bf16_t*)(ws + OFF_BIG), (const bf16_t*)(ws + OFF_W2A), MTOK, DM, DFF}; EpiResid e{p.x, p.out, 0.5f}; pg8::gemm_phase(lds, g, S, e); }
    SEAM(2)
    if (RUNS(3)) norm_rows(p.out, p.mix_norm, (bf16_t*)(ws + OFF_HN));
    SEAM(3)
    if (RUNS(4)) { S.init(MTOK, INC, gridDim.x, blockIdx.x); pg8::Gemm g{(const bf16_t*)(ws + OFF_HN), (const bf16_t*)(ws + OFF_WIN), MTOK, INC, DM}; EpiProj e{ws, p.q_norm, p.k_norm}; pg8::gemm_phase(lds, g, S, e); }
    SEAM(4)
    if (RUNS(5)) {
        const int G = gridDim.x, bx = blockIdx.x;
        if (PH_ON(10)) for (int it = bx; it < 64; it += G) hgrn_item(p, lds, it);
        if (PH_ON(11)) for (int it = bx + (bx < 64 ? ((64 - bx + G - 1) / G) * G : 0); it < 192; it += G) attn_item(p, lds, it - 64);
    }
    SEAM(5)
    if (RUNS(6)) { S.init(MTOK, DM, gridDim.x, blockIdx.x); pg8::Gemm g{(const bf16_t*)(ws + OFF_HN), (const bf16_t*)(ws + OFF_WOUT), MTOK, DM, DM}; EpiResid e{p.out, p.out, 1.0f}; pg8::gemm_phase(lds, g, S, e); }
    SEAM(6)
    if (RUNS(7)) norm_rows(p.out, p.ffn2_norm, (bf16_t*)(ws + OFF_HN));
    SEAM(7)
    if (RUNS(8)) { S.init(MTOK, 2 * DFF, gridDim.x, blockIdx.x); pg8::Gemm g{(const bf16_t*)(ws + OFF_HN), (const bf16_t*)(ws + OFF_W13B), MTOK, 2 * DFF, DM}; EpiSwiGLU e{(bf16_t*)(ws + OFF_BIG)}; pg8::gemm_phase(lds, g, S, e); }
    SEAM(8)
    if (RUNS(9)) { S.init(MTOK, DM, gridDim.x, blockIdx.x); pg8::Gemm g{(const bf16_t*)(ws + OFF_BIG), (const bf16_t*)(ws + OFF_W2B), MTOK, DM, DFF}; EpiResid e{p.out, p.out, 0.5f}; pg8::gemm_phase(lds, g, S, e); }
}

#ifndef N_LAUNCH_MODE
#define N_LAUNCH_MODE 1
#endif
extern "C" void kernel_launch(void* const* d_in, const int* in_sizes, int n_in, void* d_out, int out_size, void* d_ws, size_t ws_size, hipStream_t stream) {
    static int grid = 0;
    if (grid == 0) {
        if (n_in != 16 || ws_size < WS_END) { fprintf(stderr, "kernel_launch: unexpected n_in %d or ws %zu < %zu\n", n_in, ws_size, (size_t)WS_END); grid = -1; return; }
        int dev = 0, cus = 0, per_cu = 0;
        hipGetDevice(&dev); hipDeviceGetAttribute(&cus, hipDeviceAttributeMultiprocessorCount, dev);
        if (hipFuncSetAttribute((const void*)hymba_fwd, hipFuncAttributeMaxDynamicSharedMemorySize, LDS_BYTES) != hipSuccess) { fprintf(stderr, "kernel_launch: hipFuncSetAttribute failed\n"); grid = -1; return; }
        hipOccupancyMaxActiveBlocksPerMultiprocessor(&per_cu, (const void*)hymba_fwd, 512, LDS_BYTES);
        (void)hipGetLastError();
        if (per_cu < 1) per_cu = 1;
        grid = cus * 1;
    }
    if (grid < 0) return;
    Params p{};
    p.x = (const float*)d_in[0]; p.ffn1_norm = (const float*)d_in[1]; p.ffn1_w1 = (const float*)d_in[2]; p.ffn1_w3 = (const float*)d_in[3]; p.ffn1_w2 = (const float*)d_in[4];
    p.mix_norm = (const float*)d_in[5]; p.w_in = (const float*)d_in[6]; p.q_norm = (const float*)d_in[7]; p.k_norm = (const float*)d_in[8]; p.lb_logits = (const float*)d_in[9];
    p.hg_out_norm = (const float*)d_in[10]; p.w_out = (const float*)d_in[11]; p.ffn2_norm = (const float*)d_in[12]; p.ffn2_w1 = (const float*)d_in[13]; p.ffn2_w3 = (const float*)d_in[14]; p.ffn2_w2 = (const float*)d_in[15];
    p.out = (float*)d_out; p.ws = (unsigned char*)d_ws;
#if N_LAUNCH_MODE == 1
    int lo = 0, hi = NPHASE;
    void* args[] = {&p, &lo, &hi};
    hipError_t e = hipLaunchCooperativeKernel((const void*)hymba_fwd, dim3(grid), dim3(512), args, LDS_BYTES, stream);
    if (e != hipSuccess) fprintf(stderr, "cooperative launch failed: %s (grid %d)\n", hipGetErrorString(e), grid);
#else
    for (int ph = 0; ph < NPHASE; ++ph) hipLaunchKernelGGL(hymba_fwd, dim3(grid), dim3(512), LDS_BYTES, stream, p, ph, ph + 1);
#endif
}
```

```cpp
#include <hip/hip_runtime.h>
#include <hip/hip_cooperative_groups.h>
#include <cstdio>
namespace cg = cooperative_groups;

#define LAS __attribute__((address_space(3)))
#define DI __device__ __forceinline__
typedef unsigned short bf16_t;
typedef short bf16x8 __attribute__((ext_vector_type(8)));
typedef short s16x4 __attribute__((ext_vector_type(4)));
typedef float f32x4 __attribute__((ext_vector_type(4)));
typedef float f32x2 __attribute__((ext_vector_type(2)));
typedef unsigned u32x4 __attribute__((ext_vector_type(4)));
typedef unsigned u32x2 __attribute__((ext_vector_type(2)));
typedef __bf16 bf2_t __attribute__((ext_vector_type(2)));

constexpr int MTOK = 32768, DM = 1024, DFF = 2816, SEQ = 2048, INC = 3584;
constexpr float EPS = 1e-6f;
constexpr size_t SZ_W13 = (size_t)2 * DFF * DM * 2, SZ_W2 = (size_t)DM * DFF * 2, SZ_WIN = (size_t)INC * DM * 2, SZ_WOUT = (size_t)DM * DM * 2;
constexpr size_t OFF_W13A = 0, OFF_W2A = OFF_W13A + SZ_W13, OFF_WIN = OFF_W2A + SZ_W2, OFF_WOUT = OFF_WIN + SZ_WIN, OFF_W13B = OFF_WOUT + SZ_WOUT, OFF_W2B = OFF_W13B + SZ_W13;
constexpr size_t OFF_ROPE = OFF_W2B + SZ_W2;
constexpr size_t OFF_LB = OFF_ROPE + (size_t)SEQ * 16 * 4;
constexpr size_t OFF_HN = OFF_LB + 4096;
constexpr size_t OFF_BIG = OFF_HN + (size_t)MTOK * DM * 2;
constexpr size_t SZ_P = (size_t)MTOK * 512 * 2;
constexpr size_t OFF_Q = OFF_BIG, OFF_K = OFF_Q + SZ_P, OFF_V = OFF_K + SZ_P, OFF_HQ = OFF_V + SZ_P, OFF_HI = OFF_HQ + SZ_P, OFF_HGT = OFF_HI + SZ_P, OFF_G = OFF_HGT + SZ_P;
constexpr size_t OFF_AST = OFF_G + (size_t)MTOK * 512 * 4;
constexpr size_t OFF_AML = OFF_AST + (size_t)128 * SEQ * 64 * 4;
constexpr size_t OFF_BAR = OFF_AML + (size_t)128 * SEQ * 2 * 4;
constexpr size_t BAR_BYTES = 3456 * 4;
constexpr size_t WS_END = OFF_BAR + BAR_BYTES;
constexpr int LDS_BYTES = 131072 + 16;

struct Params {
    const float* x; const float* ffn1_norm; const float* ffn1_w1; const float* ffn1_w3; const float* ffn1_w2; const float* mix_norm; const float* w_in;
    const float* q_norm; const float* k_norm; const float* lb_logits; const float* hg_out_norm; const float* w_out; const float* ffn2_norm;
    const float* ffn2_w1; const float* ffn2_w3; const float* ffn2_w2;
    float* out; unsigned char* ws;
};

DI unsigned pk2(float lo, float hi) { f32x2 v = {lo, hi}; bf2_t r = __builtin_convertvector(v, bf2_t); return __builtin_bit_cast(unsigned, r); }
DI float bf2f(unsigned short b) { return __uint_as_float(((unsigned)b) << 16); }
DI float sigmoidf_(float v) { return __builtin_amdgcn_rcpf(1.0f + __expf(-v)); }
DI float siluf_(float v) { return v * sigmoidf_(v); }
__host__ __device__ DI int perm32(int rho) { const int n = rho >> 4, i = rho & 15; return 8 * (i >> 2) + 4 * n + (i & 3); }

namespace pg8 {
constexpr int BM = 256, BK = 64, HALF = 128, HTB = HALF * BK * 2, NXCD = 8, WGM = 8;
__host__ __device__ DI int lds_byte(int r, int c) { const int st = (r >> 4) * 2 + (c >> 5), rr = r & 15, cc = c & 31, ob = rr * 64 + cc * 2; return st * 1024 + (ob ^ (((ob >> 9) & 1) << 5)); }
__host__ __device__ DI void stage_rc(int b, int& R, int& C) { const int st = b / 1024, sb = b % 1024, swz = sb ^ (((sb >> 9) & 1) << 5); R = (st >> 1) * 16 + swz / 64; C = (st & 1) * 32 + (swz % 64) / 2; }
struct Unit { int pm, pn; };
struct Gemm { const bf16_t* A; const bf16_t* Bt; int M, N, K; };
struct StaticOrder {
    int nM, nN, nwg, G, c;
    DI void init(int M, int N, int G_, int c_) { nM = M / BM; nN = N / BM; nwg = nM * nN; G = G_; c = c_; }
    DI bool next(int i, Unit& u) const {
        const long L = (long)i * G + c; if (L >= nwg) return false;
        int wgid = (int)L; { const int q = nwg / NXCD, r = nwg % NXCD, xcd = wgid % NXCD, off = wgid / NXCD; wgid = (xcd < r ? xcd * (q + 1) : r * (q + 1) + (xcd - r) * q) + off; }
        const int nig = WGM * nN, gid = wgid / nig, fm = gid * WGM, gsz = (nM - fm) < WGM ? (nM - fm) : WGM;
        u.pm = fm + ((wgid % nig) % gsz); u.pn = (wgid % nig) / gsz; return true;
    }
};

template <class Epi>
DI void gemm_phase(LAS unsigned char* lds, const Gemm g, const StaticOrder& S, const Epi& E) {
    const int tid = threadIdx.x, wid = __builtin_amdgcn_readfirstlane(tid >> 6), lane = tid & 63, wr = wid >> 2, wc = wid & 3, fr = lane & 15, fq = lane >> 4;
    const int K = g.K, nt = K / BK;
    unsigned voffA[2];
#pragma unroll
    for (int i = 0; i < 2; ++i) { int R, C; stage_rc(tid * 16 + i * 8192, R, C); voffA[i] = (unsigned)(R * K + C) * 2u; }
    const size_t kstep = (size_t)(BK * 2);
    const size_t hstep = (size_t)HALF * K * 2;
    const size_t tstep = 2 * hstep;
    const unsigned ldsw = (unsigned)wid * 1024u;
    const int aoff = lds_byte(wr * 64 + fr, fq * 8), boff = lds_byte(wc * 32 + fr, fq * 8);
#define PG8_SA(b, h) (((b) * 2 + (h)) * HTB)
#define PG8_SB(b, h) ((4 + (b) * 2 + (h)) * HTB)
#define PG8_STAGE(bufoff, gbase) do { _Pragma("unroll") for (int _i = 0; _i < 2; ++_i) \
        __builtin_amdgcn_global_load_lds((const unsigned*)((const char*)(gbase) + voffA[_i]), (LAS unsigned*)(lds + (bufoff) + ldsw + _i * 8192), 16, 0, 0); } while (0)
#define PG8_LDA(dst, b, h) do { _Pragma("unroll") for (int m = 0; m < 4; ++m) _Pragma("unroll") for (int k = 0; k < 2; ++k) dst[m][k] = *(const LAS bf16x8*)(lds + PG8_SA(b, h) + aoff + m * 2048 + k * 1024); } while (0)
#define PG8_LDB(dst, b, h) do { _Pragma("unroll") for (int n = 0; n < 2; ++n) _Pragma("unroll") for (int k = 0; k < 2; ++k) dst[n][k] = *(const LAS bf16x8*)(lds + PG8_SB(b, h) + boff + n * 2048 + k * 1024); } while (0)
#define PG8_MMA(ai, bj, At, Bt) do { __builtin_amdgcn_s_setprio(1); _Pragma("unroll") for (int m = 0; m < 4; ++m) _Pragma("unroll") for (int n = 0; n < 2; ++n) _Pragma("unroll") for (int k = 0; k < 2; ++k) \
        acc[ai][bj][m][n] = __builtin_amdgcn_mfma_f32_16x16x32_bf16(Bt[n][k], At[m][k], acc[ai][bj][m][n], 0, 0, 0); __builtin_amdgcn_s_setprio(0); } while (0)
#define PG8_WAIT_V(n) asm volatile("s_waitcnt vmcnt(" #n ")" ::: "memory")
#define PG8_WAIT_L(n) asm volatile("s_waitcnt lgkmcnt(" #n ")" ::: "memory")
#define PG8_BAR __builtin_amdgcn_s_barrier()
#define PG8_SCHED __builtin_amdgcn_sched_barrier(0)
    Unit cur, nxt; int ui = 0;
    if (!S.next(0, cur)) return;
    f32x4 acc[2][2][4][2];
#pragma unroll
    for (int a = 0; a < 2; ++a)
#pragma unroll
        for (int b = 0; b < 2; ++b)
#pragma unroll
            for (int m = 0; m < 4; ++m)
#pragma unroll
                for (int n = 0; n < 2; ++n) acc[a][b][m][n] = (f32x4){0.f, 0.f, 0.f, 0.f};
    bf16x8 At[4][2], B0[2][2], B1[2][2];
    const char* cA = (const char*)g.A + (size_t)cur.pm * tstep; const char* cB = (const char*)g.Bt + (size_t)cur.pn * tstep;
    PG8_STAGE(PG8_SB(0, 0), cB); PG8_STAGE(PG8_SA(0, 0), cA); PG8_STAGE(PG8_SB(0, 1), cB + hstep); PG8_STAGE(PG8_SA(0, 1), cA + hstep);
    if (wr == 1) PG8_BAR;
    PG8_WAIT_V(4); PG8_BAR;
    PG8_STAGE(PG8_SB(1, 0), cB + kstep); PG8_STAGE(PG8_SA(1, 0), cA + kstep); PG8_STAGE(PG8_SB(1, 1), cB + hstep + kstep);
    PG8_WAIT_V(6); PG8_BAR;
    for (;;) {
        const bool has_next = S.next(ui + 1, nxt);
        const char* nA = has_next ? (const char*)g.A + (size_t)nxt.pm * tstep : cA; const char* nB = has_next ? (const char*)g.Bt + (size_t)nxt.pn * tstep : cB;
        for (int t = 0; t < nt; t += 2) {
            const bool last = (t == nt - 2);
            const char* a1 = cA + (size_t)(t + 1) * kstep;
            const char* a2 = last ? nA : cA + (size_t)(t + 2) * kstep; const char* b2 = last ? nB : cB + (size_t)(t + 2) * kstep;
            const char* a3 = a2 + kstep; const char* b3 = b2 + kstep;
            PG8_LDB(B0, 0, 0); PG8_SCHED; PG8_LDA(At, 0, 0); PG8_STAGE(PG8_SA(1, 1), a1 + hstep);
            PG8_WAIT_L(8); PG8_BAR; PG8_WAIT_L(0); PG8_MMA(0, 0, At, B0); PG8_BAR; PG8_SCHED;
            PG8_LDB(B1, 0, 1); PG8_STAGE(PG8_SB(0, 0), b2);
            PG8_BAR; PG8_WAIT_L(0); PG8_MMA(0, 1, At, B1); PG8_BAR;
            PG8_LDA(At, 0, 1); PG8_STAGE(PG8_SA(0, 0), a2);
            PG8_BAR; PG8_WAIT_L(0); PG8_MMA(1, 0, At, B0); PG8_BAR; PG8_SCHED;
            PG8_STAGE(PG8_SB(0, 1), b2 + hstep);
            PG8_WAIT_V(6); PG8_BAR; PG8_MMA(1, 1, At, B1); PG8_BAR;
            PG8_LDB(B0, 1, 0); PG8_SCHED; PG8_LDA(At, 1, 0); PG8_STAGE(PG8_SA(0, 1), a2 + hstep);
            PG8_WAIT_L(8); PG8_BAR; PG8_WAIT_L(0); PG8_MMA(0, 0, At, B0); PG8_BAR; PG8_SCHED;
            PG8_LDB(B1, 1, 1); PG8_STAGE(PG8_SB(1, 0), b3);
            PG8_BAR; PG8_WAIT_L(0); PG8_MMA(0, 1, At, B1); PG8_BAR;
            PG8_LDA(At, 1, 1); PG8_STAGE(PG8_SA(1, 0), a3);
            PG8_BAR; PG8_WAIT_L(0); PG8_MMA(1, 0, At, B0); PG8_BAR; PG8_SCHED;
            PG8_STAGE(PG8_SB(1, 1), b3 + hstep);
            PG8_WAIT_V(6); PG8_BAR; PG8_MMA(1, 1, At, B1); PG8_BAR;
        }
        E(acc, cur, wr, wc, fr, fq);
        if (!has_next) break;
#pragma unroll
        for (int a = 0; a < 2; ++a)
#pragma unroll
            for (int b = 0; b < 2; ++b)
#pragma unroll
                for (int m = 0; m < 4; ++m)
#pragma unroll
                    for (int n = 0; n < 2; ++n) acc[a][b][m][n] = (f32x4){0.f, 0.f, 0.f, 0.f};
        cur = nxt; cA = nA; cB = nB; ++ui;
    }
    PG8_WAIT_V(0);
    if (wr == 0) PG8_BAR;
    PG8_BAR;
#undef PG8_SA
#undef PG8_SB
#undef PG8_STAGE
#undef PG8_LDA
#undef PG8_LDB
#undef PG8_MMA
#undef PG8_WAIT_V
#undef PG8_WAIT_L
#undef PG8_BAR
#undef PG8_SCHED
}
}
using pg8::Unit;
typedef f32x4 AccT[2][2][4][2];

struct EpiSwiGLU {
    bf16_t* U;
    DI void operator()(const AccT& acc, const Unit& u, int wr, int wc, int fr, int fq) const {
        const int row0 = u.pm * 256 + wr * 64 + fr, col0 = u.pn * 128 + wc * 32 + 8 * fq;
#pragma unroll
        for (int ai = 0; ai < 2; ++ai)
#pragma unroll
            for (int m = 0; m < 4; ++m) {
                float v[8];
#pragma unroll
                for (int n = 0; n < 2; ++n)
#pragma unroll
                    for (int j = 0; j < 4; ++j) v[4 * n + j] = siluf_(acc[ai][0][m][n][j]) * acc[ai][1][m][n][j];
                u32x4 w; w.x = pk2(v[0], v[1]); w.y = pk2(v[2], v[3]); w.z = pk2(v[4], v[5]); w.w = pk2(v[6], v[7]);
                *(u32x4*)(U + (size_t)(row0 + ai * 128 + m * 16) * DFF + col0) = w;
            }
    }
};
struct EpiResid {
    const float* R; float* O; float scale;
    DI void operator()(const AccT& acc, const Unit& u, int wr, int wc, int fr, int fq) const {
        const int row0 = u.pm * 256 + wr * 64 + fr, col0 = u.pn * 256 + wc * 32 + 4 * fq;
#pragma unroll
        for (int ai = 0; ai < 2; ++ai)
#pragma unroll
            for (int m = 0; m < 4; ++m) {
                const size_t ro = (size_t)(row0 + ai * 128 + m * 16) * DM + col0;
#pragma unroll
                for (int bj = 0; bj < 2; ++bj)
#pragma unroll
                    for (int n = 0; n < 2; ++n) { const f32x4 r = *(const f32x4*)(R + ro + bj * 128 + n * 16); *(f32x4*)(O + ro + bj * 128 + n * 16) = r + acc[ai][bj][m][n] * scale; }
            }
    }
};
struct EpiProj {
    unsigned char* ws; const float* q_norm; const float* k_norm;
    DI void operator()(const AccT& acc, const Unit& u, int wr, int wc, int fr, int fq) const {
        const int sec = u.pn >> 1, cbase = 256 * (u.pn & 1) + 64 * wc + 8 * fq;
        const int row0 = u.pm * 256 + wr * 64 + fr;
        if (sec <= 1) {
            const float* gn = sec == 0 ? q_norm : k_norm;
            bf16_t* dst = (bf16_t*)(ws + (sec == 0 ? OFF_Q : OFF_K));
            const float osc = sec == 0 ? 0.125f : 1.0f;
            f32x4 gv[2][2];
#pragma unroll
            for (int bj = 0; bj < 2; ++bj)
#pragma unroll
                for (int n = 0; n < 2; ++n) gv[bj][n] = *(const f32x4*)(gn + 32 * bj + 8 * fq + 4 * n) * osc;
            const float* rope = (const float*)(ws + OFF_ROPE);
#pragma unroll
            for (int ai = 0; ai < 2; ++ai)
#pragma unroll
                for (int m = 0; m < 4; ++m) {
                    const int row = row0 + ai * 128 + m * 16;
                    float ss = 0.f;
#pragma unroll
                    for (int bj = 0; bj < 2; ++bj)
#pragma unroll
                        for (int n = 0; n < 2; ++n) { const f32x4 a = acc[ai][bj][m][n]; ss += a[0] * a[0] + a[1] * a[1] + a[2] * a[2] + a[3] * a[3]; }
                    ss += __shfl_xor(ss, 16); ss += __shfl_xor(ss, 32);
                    const float rstd = rsqrtf(ss * (1.0f / 64.0f) + EPS);
                    f32x4 y[2][2];
#pragma unroll
                    for (int bj = 0; bj < 2; ++bj)
#pragma unroll
                        for (int n = 0; n < 2; ++n) y[bj][n] = acc[ai][bj][m][n] * rstd * gv[bj][n];
                    const float* rp = rope + (size_t)(row & (SEQ - 1)) * 16;
#pragma unroll
                    for (int n = 0; n < 2; ++n) {
                        const f32x4 cs = *(const f32x4*)(rp + 4 * n), sn = *(const f32x4*)(rp + 8 + 4 * n);
                        f32x4 own = y[0][n], oth;
#pragma unroll
                        for (int j = 0; j < 4; ++j) oth[j] = __shfl_xor(own[j], 16);
                        f32x4 r0 = own * cs - oth * sn;
                        f32x4 r1 = oth * sn + own * cs;
                        y[0][n] = fq == 0 ? r0 : (fq == 1 ? r1 : own);
                    }
#pragma unroll
                    for (int bj = 0; bj < 2; ++bj) {
                        u32x4 w; w.x = pk2(y[bj][0][0], y[bj][0][1]); w.y = pk2(y[bj][0][2], y[bj][0][3]); w.z = pk2(y[bj][1][0], y[bj][1][1]); w.w = pk2(y[bj][1][2], y[bj][1][3]);
                        *(u32x4*)(dst + (size_t)row * 512 + cbase + 32 * bj) = w;
                    }
                }
        } else if (sec == 4) {
            float* dst = (float*)(ws + OFF_G);
            const float* lbt = (const float*)(ws + OFF_LB);
            f32x4 lb[2][2];
#pragma unroll
            for (int bj = 0; bj < 2; ++bj)
#pragma unroll
                for (int n = 0; n < 2; ++n) lb[bj][n] = *(const f32x4*)(lbt + cbase + 32 * bj + 4 * n);
#pragma unroll
            for (int ai = 0; ai < 2; ++ai)
#pragma unroll
                for (int m = 0; m < 4; ++m) {
                    const int row = row0 + ai * 128 + m * 16;
#pragma unroll
                    for (int bj = 0; bj < 2; ++bj)
#pragma unroll
                        for (int n = 0; n < 2; ++n) {
                            f32x4 o;
#pragma unroll
                            for (int j = 0; j < 4; ++j) { const float l = lb[bj][n][j]; o[j] = __logf(l + (1.0f - l) * sigmoidf_(acc[ai][bj][m][n][j])); }
                            *(f32x4*)(dst + (size_t)row * 512 + cbase + 32 * bj + 4 * n) = o;
                        }
                }
        } else {
            bf16_t* dst = (bf16_t*)(ws + (sec == 2 ? OFF_V : sec == 3 ? OFF_HQ : sec == 5 ? OFF_HI : OFF_HGT));
            const bool act = sec == 6;
#pragma unroll
            for (int ai = 0; ai < 2; ++ai)
#pragma unroll
                for (int m = 0; m < 4; ++m) {
                    const int row = row0 + ai * 128 + m * 16;
#pragma unroll
                    for (int bj = 0; bj < 2; ++bj) {
                        f32x4 a = acc[ai][bj][m][0], b = acc[ai][bj][m][1];
                        if (act) {
#pragma unroll
                            for (int j = 0; j < 4; ++j) { a[j] = siluf_(a[j]); b[j] = siluf_(b[j]); }
                        }
                        u32x4 w; w.x = pk2(a[0], a[1]); w.y = pk2(a[2], a[3]); w.z = pk2(b[0], b[1]); w.w = pk2(b[2], b[3]);
                        *(u32x4*)(dst + (size_t)row * 512 + cbase + 32 * bj) = w;
                    }
                }
        }
    }
};

DI void conv_tile(LAS float* t, const float* W, const float* W3, int ncols, bf16_t* Bt, int K, int s0, int k0, int kind) {
    const int tid = threadIdx.x, lane = tid & 63, kq = tid >> 6;
    const int slot = s0 + lane;
    const float* src = W; int col = slot;
    if (kind == 1) { const int pn = slot >> 8, bj = (slot >> 7) & 1, wc = (slot >> 5) & 3, r = slot & 31; src = bj ? W3 : W; col = 128 * pn + 32 * wc + perm32(r); }
    else if (kind == 2) { const int bj = (slot >> 7) & 1, wc = (slot >> 5) & 3, r = slot & 31; col = (slot & ~255) + 64 * wc + 32 * bj + perm32(r); }
    float v[8];
#pragma unroll
    for (int it = 0; it < 8; ++it) v[it] = src[(size_t)(k0 + kq + 8 * it) * ncols + col];
#pragma unroll
    for (int it = 0; it < 8; ++it) t[(kq + 8 * it) * 65 + lane] = v[it];
    __syncthreads();
    const int sl = tid >> 3, kc = tid & 7;
    float o[8];
#pragma unroll
    for (int e = 0; e < 8; ++e) o[e] = t[(8 * kc + e) * 65 + sl];
    u32x4 w; w.x = pk2(o[0], o[1]); w.y = pk2(o[2], o[3]); w.z = pk2(o[4], o[5]); w.w = pk2(o[6], o[7]);
    *(u32x4*)(Bt + (size_t)(s0 + sl) * K + k0 + 8 * kc) = w;
    __syncthreads();
}

DI void norm_rows(const float* X, const float* w, bf16_t* out) {
    const int lane = threadIdx.x & 63, gw = blockIdx.x * 8 + (threadIdx.x >> 6), nw = gridDim.x * 8;
    f32x4 wv[4];
#pragma unroll
    for (int i = 0; i < 4; ++i) wv[i] = *(const f32x4*)(w + 4 * lane + 256 * i);
    for (int row = gw; row < MTOK; row += nw) {
        const float* xr = X + (size_t)row * DM;
        f32x4 v[4]; float ss = 0.f;
#pragma unroll
        for (int i = 0; i < 4; ++i) { v[i] = *(const f32x4*)(xr + 4 * lane + 256 * i); ss += v[i][0] * v[i][0] + v[i][1] * v[i][1] + v[i][2] * v[i][2] + v[i][3] * v[i][3]; }
#pragma unroll
        for (int o = 32; o >= 1; o >>= 1) ss += __shfl_xor(ss, o);
        const float rstd = rsqrtf(ss * (1.0f / DM) + EPS);
#pragma unroll
        for (int i = 0; i < 4; ++i) { const f32x4 y = v[i] * rstd * wv[i]; u32x2 p; p.x = pk2(y[0], y[1]); p.y = pk2(y[2], y[3]); *(u32x2*)(out + (size_t)row * DM + 4 * lane + 256 * i) = p; }
    }
}

DI void phase_prep(const Params& p, LAS unsigned char* lds) {
    LAS float* t = (LAS float*)lds;
    unsigned char* ws = p.ws;
    { const int idx = blockIdx.x * 512 + threadIdx.x;
      if (idx < SEQ * 8) { const int pos = idx >> 3, i = idx & 7; const float inv = powf(500000.0f, -(float)i * 0.125f); const float ang = (float)pos * inv; float* rt = (float*)(ws + OFF_ROPE); rt[pos * 16 + i] = cosf(ang); rt[pos * 16 + 8 + i] = sinf(ang); }
      if (idx < 512) { const float l0 = p.lb_logits[idx], l1 = p.lb_logits[512 + idx]; ((float*)(ws + OFF_LB))[idx] = 1.0f / (1.0f + expf(l1 - l0)); } }
    constexpr int T13 = 88 * 16, T2 = 16 * 44, TIN = 56 * 16, TOUT = 16 * 16, TTOT = 2 * T13 + 2 * T2 + TIN + TOUT;
    for (int ti = blockIdx.x; ti < TTOT; ti += gridDim.x) {
        int r = ti;
        if (r < T13) { conv_tile(t, p.ffn1_w1, p.ffn1_w3, DFF, (bf16_t*)(ws + OFF_W13A), DM, (r >> 4) * 64, (r & 15) * 64, 1); continue; } r -= T13;
        if (r < T2) { conv_tile(t, p.ffn1_w2, nullptr, DM, (bf16_t*)(ws + OFF_W2A), DFF, (r / 44) * 64, (r % 44) * 64, 0); continue; } r -= T2;
        if (r < TIN) { conv_tile(t, p.w_in, nullptr, INC, (bf16_t*)(ws + OFF_WIN), DM, (r >> 4) * 64, (r & 15) * 64, 2); continue; } r -= TIN;
        if (r < TOUT) { conv_tile(t, p.w_out, nullptr, DM, (bf16_t*)(ws + OFF_WOUT), DM, (r >> 4) * 64, (r & 15) * 64, 0); continue; } r -= TOUT;
        if (r < T13) { conv_tile(t, p.ffn2_w1, p.ffn2_w3, DFF, (bf16_t*)(ws + OFF_W13B), DM, (r >> 4) * 64, (r & 15) * 64, 1); continue; } r -= T13;
        conv_tile(t, p.ffn2_w2, nullptr, DM, (bf16_t*)(ws + OFF_W2B), DFF, (r / 44) * 64, (r % 44) * 64, 0);
    }
    norm_rows(p.x, p.ffn1_norm, (bf16_t*)(ws + OFF_HN));
}

constexpr int AROW = 144;
DI void attn_item(const Params& p, LAS unsigned char* lds, int item) {
    const int tid = threadIdx.x, w = __builtin_amdgcn_readfirstlane(tid >> 6), lane = tid & 63, li = lane & 15, g = lane >> 4;
    const int b = item >> 3, h = item & 7;
    unsigned char* ws = p.ws;
    const bf16_t* Qg = (const bf16_t*)(ws + OFF_Q) + (size_t)b * SEQ * 512 + h * 64;
    const bf16_t* Kg = (const bf16_t*)(ws + OFF_K) + (size_t)b * SEQ * 512 + h * 64;
    const bf16_t* Vg = (const bf16_t*)(ws + OFF_V) + (size_t)b * SEQ * 512 + h * 64;
    float* ast = (float*)(ws + OFF_AST) + (size_t)item * SEQ * 64;
    float* aml = (float*)(ws + OFF_AML) + (size_t)item * SEQ * 2;
    bf16_t* mixed = (bf16_t*)(ws + OFF_HN) + (size_t)b * SEQ * DM + h * 64;
    LAS unsigned char* Ks = lds;
    LAS unsigned char* Vs = lds + 256 * AROW;
#pragma unroll 1
    for (int pat = 0; pat < 3; ++pat) {
        const int d = pat == 0 ? 16 : (pat == 1 ? 4 : 1);
        const int nblk = SEQ / d / 128;
#pragma unroll 1
        for (int sp = 0; sp < 16; ++sp) {
            const int res = sp / nblk, blk = sp % nblk, P0 = blk * 128;
            __syncthreads();
#pragma unroll
            for (int i = 0; i < 4; ++i) {
                const int c = tid + 512 * i, row = c >> 3, ch = c & 7;
                const int pp = P0 - 128 + row;
                u32x4 kv = {0u, 0u, 0u, 0u}, vv = {0u, 0u, 0u, 0u};
                if (pp >= 0) { const size_t off = (size_t)(res + d * pp) * 512 + 8 * ch; kv = *(const u32x4*)(Kg + off); vv = *(const u32x4*)(Vg + off); }
                *(LAS u32x4*)(Ks + row * AROW + 16 * ch) = kv;
                *(LAS u32x4*)(Vs + row * AROW + 16 * ch) = vv;
            }
            __syncthreads();
            const int tq = res + d * (P0 + 16 * w + li);
            const bf16x8 qf0 = *(const bf16x8*)(Qg + (size_t)tq * 512 + 8 * g), qf1 = *(const bf16x8*)(Qg + (size_t)tq * 512 + 32 + 8 * g);
            const int kt_lo = blk == 0 ? (8 - w) : 0;
            f32x4 s[9];
#pragma unroll
            for (int kt = 0; kt < 9; ++kt) {
                if (kt >= kt_lo) {
                    const LAS unsigned char* kr = Ks + (16 * (w + kt) + li) * AROW + 16 * g;
                    const bf16x8 kf0 = *(const LAS bf16x8*)kr, kf1 = *(const LAS bf16x8*)(kr + 64);
                    f32x4 c = {0.f, 0.f, 0.f, 0.f};
                    c = __builtin_amdgcn_mfma_f32_16x16x32_bf16(kf0, qf0, c, 0, 0, 0);
                    c = __builtin_amdgcn_mfma_f32_16x16x32_bf16(kf1, qf1, c, 0, 0, 0);
                    s[kt] = c;
                } else s[kt] = (f32x4){-1e30f, -1e30f, -1e30f, -1e30f};
            }
#pragma unroll
            for (int j = 0; j < 4; ++j) { if (4 * g + j < li) s[0][j] = -1e30f; if (4 * g + j > li) s[8][j] = -1e30f; }
            float mx = -1e30f;
#pragma unroll
            for (int kt = 0; kt < 9; ++kt)
#pragma unroll
                for (int j = 0; j < 4; ++j) mx = fmaxf(mx, s[kt][j]);
            mx = fmaxf(mx, __shfl_xor(mx, 16)); mx = fmaxf(mx, __shfl_xor(mx, 32));
            float ls = 0.f;
#pragma unroll
            for (int kt = 0; kt < 9; ++kt)
#pragma unroll
                for (int j = 0; j < 4; ++j) { const float e = __expf(s[kt][j] - mx); s[kt][j] = e; ls += e; }
            ls += __shfl_xor(ls, 16); ls += __shfl_xor(ls, 32);
            f32x4 o[4];
#pragma unroll
            for (int dt = 0; dt < 4; ++dt) o[dt] = (f32x4){0.f, 0.f, 0.f, 0.f};
#pragma unroll
            for (int c = 0; c < 5; ++c) {
                if (2 * c + 1 >= kt_lo || c == 4) {
                    u32x4 pw; pw.x = pk2(s[2 * c][0], s[2 * c][1]); pw.y = pk2(s[2 * c][2], s[2 * c][3]);
                    if (c < 4) { pw.z = pk2(s[2 * c + 1][0], s[2 * c + 1][1]); pw.w = pk2(s[2 * c + 1][2], s[2 * c + 1][3]); } else { pw.z = 0u; pw.w = 0u; }
                    const bf16x8 pf = __builtin_bit_cast(bf16x8, pw);
                    const LAS unsigned char* vr = Vs + (16 * (w + 2 * c) + 4 * g + (li >> 2)) * AROW + 8 * (li & 3);
#pragma unroll
                    for (int dt = 0; dt < 4; ++dt) {
                        const s16x4 t0 = __builtin_amdgcn_ds_read_tr16_b64_v4i16((LAS s16x4*)(vr + 32 * dt));
                        s16x4 t1 = {0, 0, 0, 0};
                        if (c < 4) t1 = __builtin_amdgcn_ds_read_tr16_b64_v4i16((LAS s16x4*)(vr + 16 * AROW + 32 * dt));
                        const bf16x8 vf = {t0[0], t0[1], t0[2], t0[3], t1[0], t1[1], t1[2], t1[3]};
                        o[dt] = __builtin_amdgcn_mfma_f32_16x16x32_bf16(vf, pf, o[dt], 0, 0, 0);
                    }
                }
            }
            float* sa = ast + (size_t)tq * 64 + 4 * g;
            float* sm = aml + (size_t)tq * 2;
            if (pat > 0) {
                const float mo = sm[0], lo = sm[1];
                const float mn = fmaxf(mo, mx), a = __expf(mo - mn), bb = __expf(mx - mn);
#pragma unroll
                for (int dt = 0; dt < 4; ++dt) { const f32x4 old = *(const f32x4*)(sa + 16 * dt); o[dt] = old * a + o[dt] * bb; }
                ls = lo * a + ls * bb; mx = mn;
            }
            if (pat < 2) {
#pragma unroll
                for (int dt = 0; dt < 4; ++dt) *(f32x4*)(sa + 16 * dt) = o[dt];
                if (g == 0) { sm[0] = mx; sm[1] = ls; }
            } else {
                const float il = 1.0f / ls;
#pragma unroll
                for (int dt = 0; dt < 4; ++dt) { u32x2 pw; pw.x = pk2(o[dt][0] * il, o[dt][1] * il); pw.y = pk2(o[dt][2] * il, o[dt][3] * il); *(u32x2*)(mixed + (size_t)tq * DM + 16 * dt + 4 * g) = pw; }
            }
        }
    }
    __syncthreads();
}

constexpr int H_QD = 0, H_KD = 17408, H_KLT = 34816, H_VS = 53248, H_ATT = 70656, H_DEC = 79872, H_CS = 80384, H_SSQ = 82432;
DI void hgrn_item(const Params& p, LAS unsigned char* lds, int item) {
    const int tid = threadIdx.x, w = __builtin_amdgcn_readfirstlane(tid >> 6), lane = tid & 63, li = lane & 15, g = lane >> 4;
    const int b = item >> 2, h = item & 3, cb = h * 128;
    unsigned char* ws = p.ws;
    const bf16_t* HQ = (const bf16_t*)(ws + OFF_HQ) + (size_t)b * SEQ * 512 + cb;
    const bf16_t* HI = (const bf16_t*)(ws + OFF_HI) + (size_t)b * SEQ * 512 + cb;
    const bf16_t* HG = (const bf16_t*)(ws + OFF_HGT) + (size_t)b * SEQ * 512 + cb;
    const float* GG = (const float*)(ws + OFF_G) + (size_t)b * SEQ * 512 + cb;
    bf16_t* mixed = (bf16_t*)(ws + OFF_HN) + (size_t)b * SEQ * DM + 512 + cb;
    LAS float* CS = (LAS float*)(lds + H_CS);
    LAS float* DEC = (LAS float*)(lds + H_DEC);
    LAS float* SSQ = (LAS float*)(lds + H_SSQ);
    f32x4 St[8];
#pragma unroll
    for (int kt = 0; kt < 8; ++kt) St[kt] = (f32x4){0.f, 0.f, 0.f, 0.f};
    const f32x4 gain = *(const f32x4*)(p.hg_out_norm + 16 * w + 4 * g);
    const int k = tid & 127, tqq = tid >> 7;
#pragma unroll 1
    for (int n = 0; n < 32; ++n) {
        const int t0 = n * 64;
        {
            float gc[16], qv[16];
#pragma unroll
            for (int e = 0; e < 16; ++e) { const size_t o = (size_t)(t0 + 16 * tqq + e) * 512 + k; gc[e] = GG[o]; qv[e] = bf2f(HQ[o]); }
            float kk[16];
#pragma unroll
            for (int e = 0; e < 16; ++e) kk[e] = 1.0f - __expf(gc[e]);
#pragma unroll
            for (int e = 1; e < 16; ++e) gc[e] += gc[e - 1];
            CS[tqq * 128 + k] = gc[15];
#pragma unroll
            for (int i = 0; i < 2; ++i) { const int c = tid + 512 * i, row = c >> 4, ch = c & 15; *(LAS u32x4*)(lds + H_VS + row * 272 + 16 * ch) = *(const u32x4*)(HI + (size_t)(t0 + row) * 512 + 8 * ch); }
            __syncthreads();
            const float c0 = CS[k], c1 = CS[128 + k], c2 = CS[256 + k], c3 = CS[384 + k];
            const float off = tqq == 0 ? 0.f : (tqq == 1 ? c0 : (tqq == 2 ? c0 + c1 : c0 + c1 + c2));
            const float gl = c0 + c1 + c2 + c3;
            if (tqq == 0) DEC[k] = __expf(gl);
            unsigned klp[8];
            float klprev = 0.f;
#pragma unroll
            for (int e = 0; e < 16; ++e) {
                const float G = off + gc[e];
                const float qd = qv[e] * __expf(G), kd = kk[e] * __expf(-G), kl = kk[e] * __expf(gl - G);
                const int t = 16 * tqq + e;
                *(LAS bf16_t*)(lds + H_QD + t * 272 + 2 * k) = (bf16_t)(pk2(qd, 0.f) & 0xffffu);
                *(LAS bf16_t*)(lds + H_KD + t * 272 + 2 * k) = (bf16_t)(pk2(kd, 0.f) & 0xffffu);
                if (e & 1) klp[e >> 1] = pk2(klprev, kl); else klprev = kl;
            }
            *(LAS u32x4*)(lds + H_KLT + k * 144 + 32 * tqq) = (u32x4){klp[0], klp[1], klp[2], klp[3]};
            *(LAS u32x4*)(lds + H_KLT + k * 144 + 32 * tqq + 16) = (u32x4){klp[4], klp[5], klp[6], klp[7]};
        }
        __syncthreads();
        {
            const int ti = w >> 1;
#pragma unroll
            for (int q = 0; q < 2; ++q) {
                const int si = 2 * (w & 1) + q;
                f32x4 c = {0.f, 0.f, 0.f, 0.f};
                if (si <= ti) {
#pragma unroll
                    for (int kc = 0; kc < 4; ++kc) {
                        const bf16x8 a = *(const LAS bf16x8*)(lds + H_KD + (16 * si + li) * 272 + 64 * kc + 16 * g);
                        const bf16x8 bq = *(const LAS bf16x8*)(lds + H_QD + (16 * ti + li) * 272 + 64 * kc + 16 * g);
                        c = __builtin_amdgcn_mfma_f32_16x16x32_bf16(a, bq, c, 0, 0, 0);
                    }
                    if (si == ti) {
#pragma unroll
                        for (int j = 0; j < 4; ++j) if (4 * g + j > li) c[j] = 0.f;
                    }
                }
                u32x2 pw; pw.x = pk2(c[0], c[1]); pw.y = pk2(c[2], c[3]);
                *(LAS u32x2*)(lds + H_ATT + (16 * ti + li) * 144 + 32 * si + 8 * g) = pw;
            }
        }
        __syncthreads();
        f32x4 o[4];
        {
            bf16x8 vf[2];
#pragma unroll
            for (int tc = 0; tc < 2; ++tc) {
                const LAS unsigned char* vr = lds + H_VS + (32 * tc + 8 * g + (li >> 2)) * 272 + 32 * w + 8 * (li & 3);
                const s16x4 a0 = __builtin_amdgcn_ds_read_tr16_b64_v4i16((LAS s16x4*)vr);
                const s16x4 a1 = __builtin_amdgcn_ds_read_tr16_b64_v4i16((LAS s16x4*)(vr + 4 * 272));
                vf[tc] = (bf16x8){a0[0], a0[1], a0[2], a0[3], a1[0], a1[1], a1[2], a1[3]};
            }
            bf16x8 sf[4];
#pragma unroll
            for (int pr = 0; pr < 4; ++pr) {
                u32x4 pw; pw.x = pk2(St[2 * pr][0], St[2 * pr][1]); pw.y = pk2(St[2 * pr][2], St[2 * pr][3]); pw.z = pk2(St[2 * pr + 1][0], St[2 * pr + 1][1]); pw.w = pk2(St[2 * pr + 1][2], St[2 * pr + 1][3]);
                sf[pr] = __builtin_bit_cast(bf16x8, pw);
            }
#pragma unroll
            for (int tt = 0; tt < 4; ++tt) {
                f32x4 c = {0.f, 0.f, 0.f, 0.f};
#pragma unroll
                for (int sc = 0; sc < 2; ++sc) {
                    const bf16x8 af = *(const LAS bf16x8*)(lds + H_ATT + (16 * tt + li) * 144 + 64 * sc + 16 * g);
                    c = __builtin_amdgcn_mfma_f32_16x16x32_bf16(vf[sc], af, c, 0, 0, 0);
                }
#pragma unroll
                for (int pr = 0; pr < 4; ++pr) {
                    const LAS unsigned char* qr = lds + H_QD + (16 * tt + li) * 272 + 64 * pr + 8 * g;
                    const u32x2 q0 = *(const LAS u32x2*)qr, q1 = *(const LAS u32x2*)(qr + 32);
                    const bf16x8 qf = __builtin_bit_cast(bf16x8, ((u32x4){q0.x, q0.y, q1.x, q1.y}));
                    c = __builtin_amdgcn_mfma_f32_16x16x32_bf16(sf[pr], qf, c, 0, 0, 0);
                }
                o[tt] = c;
            }
#pragma unroll
            for (int kt = 0; kt < 8; ++kt) {
                const f32x4 dec = *(const LAS f32x4*)(DEC + 16 * kt + 4 * g);
                f32x4 c = St[kt] * dec;
#pragma unroll
                for (int tc = 0; tc < 2; ++tc) {
                    const bf16x8 kf = *(const LAS bf16x8*)(lds + H_KLT + (16 * kt + li) * 144 + 64 * tc + 16 * g);
                    c = __builtin_amdgcn_mfma_f32_16x16x32_bf16(kf, vf[tc], c, 0, 0, 0);
                }
                St[kt] = c;
            }
#pragma unroll
            for (int tt = 0; tt < 4; ++tt) {
                float ss = o[tt][0] * o[tt][0] + o[tt][1] * o[tt][1] + o[tt][2] * o[tt][2] + o[tt][3] * o[tt][3];
                ss += __shfl_xor(ss, 16); ss += __shfl_xor(ss, 32);
                if (g == 0) SSQ[(16 * tt + li) * 8 + w] = ss;
            }
        }
        __syncthreads();
#pragma unroll
        for (int tt = 0; tt < 4; ++tt) {
            const int t = 16 * tt + li;
            const f32x4 s0 = *(const LAS f32x4*)(SSQ + t * 8), s1 = *(const LAS f32x4*)(SSQ + t * 8 + 4);
            const float tot = (s0[0] + s0[1]) + (s0[2] + s0[3]) + (s1[0] + s1[1]) + (s1[2] + s1[3]);
            const float rstd = rsqrtf(tot * (1.0f / 128.0f) + EPS);
            const u32x2 gw = *(const u32x2*)(HG + (size_t)(t0 + t) * 512 + 16 * w + 4 * g);
            const float g0 = __uint_as_float(gw.x << 16), g1 = __uint_as_float(gw.x & 0xffff0000u), g2 = __uint_as_float(gw.y << 16), g3 = __uint_as_float(gw.y & 0xffff0000u);
            u32x2 pw; pw.x = pk2(o[tt][0] * rstd * gain[0] * g0, o[tt][1] * rstd * gain[1] * g1); pw.y = pk2(o[tt][2] * rstd * gain[2] * g2, o[tt][3] * rstd * gain[3] * g3);
            *(u32x2*)(mixed + (size_t)(t0 + t) * DM + 16 * w + 4 * g) = pw;
        }
    }
    __syncthreads();
}

#define XB_TMO      128
#define XB_XCNT(j)  (256  + 64 * (j))
#define XB_XSUB(j)  (1280 + 64 * (j))
#define XB_XGEN(j)  (2304 + 64 * (j))
#define XB_TOP      3328
#define XB_TOPGEN   3392
#define XCD_BAR_WORDS 3456
#define XB_SPIN_CAP (1u << 22)
DI unsigned xb_ld(unsigned* p)              { return __hip_atomic_load(p, __ATOMIC_RELAXED, __HIP_MEMORY_SCOPE_AGENT); }
DI unsigned xb_add(unsigned* p, unsigned v) { return __hip_atomic_fetch_add(p, v, __ATOMIC_RELAXED, __HIP_MEMORY_SCOPE_AGENT); }
DI unsigned xb_xcc_id() { return (unsigned)__builtin_amdgcn_s_getreg((3 << 11) | 20) & 0xFu; }
#define XB_SPIN(cond, bar) do { unsigned _sp = 0; while (cond) { __builtin_amdgcn_s_sleep(1); \
    if ((++_sp & 255u) == 0u) { if (xb_ld(&(bar)[XB_TMO])) break; if (_sp > XB_SPIN_CAP) { atomicAdd(&(bar)[XB_TMO], 1u); break; } } } } while (0)
struct XcdBarrier { unsigned* bar; unsigned x; volatile LAS unsigned* st; };
DI XcdBarrier xcd_barrier_post(unsigned* bar, volatile LAS unsigned* st) {
    XcdBarrier b; b.bar = bar; b.x = xb_xcc_id(); b.st = st;
    if (threadIdx.x == 0) (void)xb_add(&bar[XB_XCNT(b.x)], 1u);
    return b;
}
DI void xcd_barrier_complete(unsigned* bar, unsigned x, unsigned& nloc, unsigned& nx) {
    const unsigned G = gridDim.x * gridDim.y * gridDim.z;
    unsigned sum, cnt, mine, sp = 0u;
    for (;;) {
        sum = 0u; cnt = 0u; mine = 0u;
#pragma unroll
        for (unsigned j = 0; j < 16; ++j) { const unsigned c = xb_ld(&bar[XB_XCNT(j)]); sum += c; cnt += (c > 0u) ? 1u : 0u; mine = (j == x) ? c : mine; }
        if (sum == G) break;
        __builtin_amdgcn_s_sleep(1);
        if ((++sp & 255u) == 0u) { if (xb_ld(&bar[XB_TMO])) break; if (sp > XB_SPIN_CAP) { atomicAdd(&bar[XB_TMO], 1u); break; } }
    }
    nloc = mine > 0u ? mine : 1u; nx = cnt > 0u ? cnt : 1u;
}
DI void xcd_barrier(const XcdBarrier& b) {
    asm volatile("s_waitcnt vmcnt(0)" ::: "memory");
    __syncthreads();
    if (threadIdx.x == 0) {
        unsigned* bar = b.bar;
        __builtin_amdgcn_s_waitcnt(0);
        unsigned nloc = b.st[0], nx = b.st[1];
        if (nloc == 0u) { xcd_barrier_complete(bar, b.x, nloc, nx); b.st[0] = nloc; b.st[1] = nx; }
        const unsigned old = xb_add(&bar[XB_XSUB(b.x)], 1u);
        const unsigned gen = old / nloc;
        if (old + 1u == (gen + 1u) * nloc) {
            __builtin_amdgcn_fence(__ATOMIC_RELEASE, "agent");
            asm volatile("s_waitcnt vmcnt(0)" ::: "memory");
            const unsigned og = xb_add(&bar[XB_TOP], 1u);
            const unsigned tg = og / nx;
            if (og + 1u == (tg + 1u) * nx) xb_add(&bar[XB_TOPGEN], 1u);
            else XB_SPIN(xb_ld(&bar[XB_TOPGEN]) == tg, bar);
            __builtin_amdgcn_fence(__ATOMIC_ACQUIRE, "agent");
            xb_add(&bar[XB_XGEN(b.x)], 1u);
            asm volatile("s_waitcnt vmcnt(0)" ::: "memory");
        } else {
            XB_SPIN(xb_ld(&bar[XB_XGEN(b.x)]) == gen, bar);
            __builtin_amdgcn_fence(__ATOMIC_ACQUIRE, "agent");
            asm volatile("s_waitcnt vmcnt(0)" ::: "memory");
        }
    }
    __syncthreads();
}

constexpr int NPHASE = 10;
#ifndef PHASE_MASK
#define PHASE_MASK 0xfff
#endif
#define PH_ON(n) ((PHASE_MASK >> (n)) & 1)
__global__ void __launch_bounds__(512, 2) hymba_fwd(Params p, int ph_lo, int ph_hi) {
    extern __shared__ __attribute__((aligned(16))) unsigned char shm[];
    LAS unsigned char* lds = (LAS unsigned char*)shm;
    unsigned char* ws = p.ws;
    pg8::StaticOrder S;
    volatile LAS unsigned* xst = (volatile LAS unsigned*)(lds + 131072);
    if (threadIdx.x == 0) { xst[0] = 0u; xst[1] = 0u; }
    __syncthreads();
    XcdBarrier xb; xb.bar = (unsigned*)(ws + OFF_BAR); xb.x = 0; xb.st = xst;
    if (ph_hi - ph_lo > 1) xb = xcd_barrier_post((unsigned*)(ws + OFF_BAR), xst);
    if (ph_lo == -12345) cg::this_grid().sync();
#define SEAM(n) if (ph_lo <= (n) && (n) + 1 < ph_hi) xcd_barrier(xb);
#define RUNS(n) (PH_ON(n) && ph_lo <= (n) && (n) < ph_hi)
#ifndef DUPMASK
#define DUPMASK 0
#endif
#define DUP(n) ((DUPMASK >> (n)) & 1)
    if (RUNS(0)) { phase_prep(p, lds); }
    if (RUNS(0) && DUP(0)) { phase_prep(p, lds); }
    SEAM(0)
    if (RUNS(1)) { { S.init(MTOK, 2 * DFF, gridDim.x, blockIdx.x); pg8::Gemm g{(const bf16_t*)(ws + OFF_HN), (const bf16_t*)(ws + OFF_W13A), MTOK, 2 * DFF, DM}; EpiSwiGLU e{(bf16_t*)(ws + OFF_BIG)}; pg8::gemm_phase(lds, g, S, e); } }
    if (RUNS(1) && DUP(1)) { { S.init(MTOK, 2 * DFF, gridDim.x, blockIdx.x); pg8::Gemm g{(const bf16_t*)(ws + OFF_HN), (const bf16_t*)(ws + OFF_W13A), MTOK, 2 * DFF, DM}; EpiSwiGLU e{(bf16_t*)(ws + OFF_BIG)}; pg8::gemm_phase(lds, g, S, e); } }
    SEAM(1)
    if (RUNS(2)) { { S.init(MTOK, DM, gridDim.x, blockIdx.x); pg8::Gemm g{(const bf16_t*)(ws + OFF_BIG), (const bf16_t*)(ws + OFF_W2A), MTOK, DM, DFF}; EpiResid e{p.x, p.out, 0.5f}; pg8::gemm_phase(lds, g, S, e); } }
    if (RUNS(2) && DUP(2)) { { S.init(MTOK, DM, gridDim.x, blockIdx.x); pg8::Gemm g{(const bf16_t*)(ws + OFF_BIG), (const bf16_t*)(ws + OFF_W2A), MTOK, DM, DFF}; EpiResid e{p.x, p.out, 0.5f}; pg8::gemm_phase(lds, g, S, e); } }
    SEAM(2)
    if (RUNS(3)) { norm_rows(p.out, p.mix_norm, (bf16_t*)(ws + OFF_HN)); }
    if (RUNS(3) && DUP(3)) { norm_rows(p.out, p.mix_norm, (bf16_t*)(ws + OFF_HN)); }
    SEAM(3)
    if (RUNS(4)) { { S.init(MTOK, INC, gridDim.x, blockIdx.x); pg8::Gemm g{(const bf16_t*)(ws + OFF_HN), (const bf16_t*)(ws + OFF_WIN), MTOK, INC, DM}; EpiProj e{ws, p.q_norm, p.k_norm}; pg8::gemm_phase(lds, g, S, e); } }
    if (RUNS(4) && DUP(4)) { { S.init(MTOK, INC, gridDim.x, blockIdx.x); pg8::Gemm g{(const bf16_t*)(ws + OFF_HN), (const bf16_t*)(ws + OFF_WIN), MTOK, INC, DM}; EpiProj e{ws, p.q_norm, p.k_norm}; pg8::gemm_phase(lds, g, S, e); } }
    SEAM(4)
    if (RUNS(5)) {
        const int G = gridDim.x, bx = blockIdx.x;
        if (PH_ON(10)) for (int it = bx; it < 64; it += G) hgrn_item(p, lds, it);
        if (PH_ON(11)) for (int it = bx + (bx < 64 ? ((64 - bx + G - 1) / G) * G : 0); it < 192; it += G) attn_item(p, lds, it - 64);
    }
    if (RUNS(5) && (DUP(10) || DUP(11))) {
        const int G = gridDim.x, bx = blockIdx.x;
        if (DUP(10)) for (int it = bx; it < 64; it += G) hgrn_item(p, lds, it);
        if (DUP(11)) for (int it = bx + (bx < 64 ? ((64 - bx + G - 1) / G) * G : 0); it < 192; it += G) attn_item(p, lds, it - 64);
    }
    SEAM(5)
    if (RUNS(6)) { { S.init(MTOK, DM, gridDim.x, blockIdx.x); pg8::Gemm g{(const bf16_t*)(ws + OFF_HN), (const bf16_t*)(ws + OFF_WOUT), MTOK, DM, DM}; EpiResid e{p.out, p.out, 1.0f}; pg8::gemm_phase(lds, g, S, e); } }
    if (RUNS(6) && DUP(6)) { { S.init(MTOK, DM, gridDim.x, blockIdx.x); pg8::Gemm g{(const bf16_t*)(ws + OFF_HN), (const bf16_t*)(ws + OFF_WOUT), MTOK, DM, DM}; EpiResid e{p.out, p.out, 1.0f}; pg8::gemm_phase(lds, g, S, e); } }
    SEAM(6)
    if (RUNS(7)) { norm_rows(p.out, p.ffn2_norm, (bf16_t*)(ws + OFF_HN)); }
    if (RUNS(7) && DUP(7)) { norm_rows(p.out, p.ffn2_norm, (bf16_t*)(ws + OFF_HN)); }
    SEAM(7)
    if (RUNS(8)) { { S.init(MTOK, 2 * DFF, gridDim.x, blockIdx.x); pg8::Gemm g{(const bf16_t*)(ws + OFF_HN), (const bf16_t*)(ws + OFF_W13B), MTOK, 2 * DFF, DM}; EpiSwiGLU e{(bf16_t*)(ws + OFF_BIG)}; pg8::gemm_phase(lds, g, S, e); } }
    if (RUNS(8) && DUP(8)) { { S.init(MTOK, 2 * DFF, gridDim.x, blockIdx.x); pg8::Gemm g{(const bf16_t*)(ws + OFF_HN), (const bf16_t*)(ws + OFF_W13B), MTOK, 2 * DFF, DM}; EpiSwiGLU e{(bf16_t*)(ws + OFF_BIG)}; pg8::gemm_phase(lds, g, S, e); } }
    SEAM(8)
    if (RUNS(9)) { { S.init(MTOK, DM, gridDim.x, blockIdx.x); pg8::Gemm g{(const bf16_t*)(ws + OFF_BIG), (const bf16_t*)(ws + OFF_W2B), MTOK, DM, DFF}; EpiResid e{p.out, p.out, 0.5f}; pg8::gemm_phase(lds, g, S, e); } }
    if (RUNS(9) && DUP(9)) { { S.init(MTOK, DM, gridDim.x, blockIdx.x); pg8::Gemm g{(const bf16_t*)(ws + OFF_BIG), (const bf16_t*)(ws + OFF_W2B), MTOK, DM, DFF}; EpiResid e{p.out, p.out, 0.5f}; pg8::gemm_phase(lds, g, S, e); } }
}

#ifndef N_LAUNCH_MODE
#define N_LAUNCH_MODE 1
#endif
extern "C" void kernel_launch(void* const* d_in, const int* in_sizes, int n_in, void* d_out, int out_size, void* d_ws, size_t ws_size, hipStream_t stream) {
    static int grid = 0;
    if (grid == 0) {
        if (n_in != 16 || ws_size < WS_END) { fprintf(stderr, "kernel_launch: unexpected n_in %d or ws %zu < %zu\n", n_in, ws_size, (size_t)WS_END); grid = -1; return; }
        int dev = 0, cus = 0, per_cu = 0;
        hipGetDevice(&dev); hipDeviceGetAttribute(&cus, hipDeviceAttributeMultiprocessorCount, dev);
        if (hipFuncSetAttribute((const void*)hymba_fwd, hipFuncAttributeMaxDynamicSharedMemorySize, LDS_BYTES) != hipSuccess) { fprintf(stderr, "kernel_launch: hipFuncSetAttribute failed\n"); grid = -1; return; }
        hipOccupancyMaxActiveBlocksPerMultiprocessor(&per_cu, (const void*)hymba_fwd, 512, LDS_BYTES);
        (void)hipGetLastError();
        if (per_cu < 1) per_cu = 1;
        grid = cus * 1;
    }
    if (grid < 0) return;
    Params p{};
    p.x = (const float*)d_in[0]; p.ffn1_norm = (const float*)d_in[1]; p.ffn1_w1 = (const float*)d_in[2]; p.ffn1_w3 = (const float*)d_in[3]; p.ffn1_w2 = (const float*)d_in[4];
    p.mix_norm = (const float*)d_in[5]; p.w_in = (const float*)d_in[6]; p.q_norm = (const float*)d_in[7]; p.k_norm = (const float*)d_in[8]; p.lb_logits = (const float*)d_in[9];
    p.hg_out_norm = (const float*)d_in[10]; p.w_out = (const float*)d_in[11]; p.ffn2_norm = (const float*)d_in[12]; p.ffn2_w1 = (const float*)d_in[13]; p.ffn2_w3 = (const float*)d_in[14]; p.ffn2_w2 = (const float*)d_in[15];
    p.out = (float*)d_out; p.ws = (unsigned char*)d_ws;
#if N_LAUNCH_MODE == 1
    if (hipMemsetAsync((char*)d_ws + OFF_BAR, 0, BAR_BYTES, stream) != hipSuccess) { fprintf(stderr, "kernel_launch: memset of barrier words failed\n"); return; }
    int lo = 0, hi = NPHASE;
    void* args[] = {&p, &lo, &hi};
    hipError_t e = hipLaunchCooperativeKernel((const void*)hymba_fwd, dim3(grid), dim3(512), args, LDS_BYTES, stream);
    if (e != hipSuccess) fprintf(stderr, "cooperative launch failed: %s (grid %d)\n", hipGetErrorString(e), grid);
#else
    for (int ph = 0; ph < NPHASE; ++ph) hipLaunchKernelGGL(hymba_fwd, dim3(grid), dim3(512), LDS_BYTES, stream, p, ph, ph + 1);
#endif
}
```
